# Optimizing an MI355X kernel written in HIP

```python
import math
import jax, jax.numpy as jnp
from jax import lax
import numpy as np

D_MODEL = 1024
BATCH = 4
SEQ = 4096
DEPTH = 2

HEAD_DIM = 64
HA = 8
DIL_PATTERNS = ((128, 1), (512, 4), (2048, 16))
HB = 4
C_CONV = 512
CONV_K = 31
D_FF = 2816
N_BUCKETS = 32
REL_MAX_DIST = 2048
BLK = 128
MIX_W = 512
A_W = HA * HEAD_DIM
B_W = HB * 2 * HEAD_DIM
IN_W = 3 * A_W + 3 * B_W + 2 * C_CONV
N_BRANCH = 3
EPS = 1e-6
NEG = -1e30

kernel_name = "hybrid_gated_dilated_diff_conformer_block"


def rmsnorm(x, g):
    xf = x.astype(jnp.float32)
    y = xf * lax.rsqrt(jnp.mean(xf * xf, axis=-1, keepdims=True) + EPS)
    return (y * g.astype(jnp.float32)).astype(x.dtype)


def layernorm(x, g, b):
    xf = x.astype(jnp.float32)
    mu = jnp.mean(xf, axis=-1, keepdims=True)
    var = jnp.mean(jnp.square(xf - mu), axis=-1, keepdims=True)
    y = (xf - mu) * lax.rsqrt(var + EPS) * g.astype(jnp.float32) + b.astype(jnp.float32)
    return y.astype(x.dtype)


def modulate(h, shift, scale):
    return h * (1.0 + scale[:, None, :]) + shift[:, None, :]


def swiglu(h, w_up, w_down):
    gate, up = jnp.split(h @ w_up, 2, axis=-1)
    return (jax.nn.silu(gate) * up) @ w_down


def t5_bucket(dist):
    max_exact = N_BUCKETS // 2
    d = jnp.maximum(dist.astype(jnp.float32), 1.0)
    large = max_exact + (jnp.log(d / max_exact) / math.log(REL_MAX_DIST / max_exact)
                         * (N_BUCKETS - max_exact)).astype(jnp.int32)
    large = jnp.minimum(large, N_BUCKETS - 1)
    return jnp.where(dist < max_exact, dist, large)


def dilated_window_attn(q, k, v, window, dilation, bias_table):
    b, s, h, hd = q.shape
    steps = window // dilation
    L = s // dilation
    nb = -(-L // BLK)
    Lp = nb * BLK

    def to_sub(t):
        t = t.reshape(b, L, dilation, h, hd).transpose(0, 2, 3, 1, 4)
        t = jnp.pad(t, ((0, 0), (0, 0), (0, 0), (0, Lp - L), (0, 0)))
        return t.reshape(b, dilation, h, nb, BLK, hd)

    def with_prev(t):
        prev = jnp.pad(t[:, :, :, :-1], ((0, 0), (0, 0), (0, 0), (1, 0), (0, 0), (0, 0)))
        return jnp.concatenate([prev, t], axis=-2)

    qs = to_sub(q)
    kw = with_prev(to_sub(k))
    vw = with_prev(to_sub(v))
    logits = jnp.einsum('bdhnqc,bdhnkc->bdhnqk', qs, kw).astype(jnp.float32) / math.sqrt(hd)
    i = jnp.arange(BLK)[:, None]
    j = jnp.arange(2 * BLK)[None, :]
    rel = i + BLK - j
    valid = ((rel >= 0) & (rel <= steps))[None] & ((jnp.arange(nb)[:, None, None] > 0) | (j >= BLK)[None])
    bias = jnp.moveaxis(bias_table[t5_bucket(jnp.maximum(rel, 0) * dilation)], -1, 0)
    logits = jnp.where(valid, logits + bias[:, None].astype(jnp.float32), NEG)
    m = jnp.max(logits, axis=-1, keepdims=True)
    p = jnp.exp(logits - m)
    den = jnp.sum(p, axis=-1, keepdims=True)
    o = jnp.einsum('bdhnqk,bdhnkc->bdhnqc', p.astype(vw.dtype), vw).astype(jnp.float32) / den
    lse = (m + jnp.log(den))[..., 0]
    o = o.reshape(b, dilation, h, Lp, hd)[:, :, :, :L].transpose(0, 3, 1, 2, 4).reshape(b, s, h, hd)
    lse = lse.reshape(b, dilation, h, Lp)[:, :, :, :L].transpose(0, 3, 1, 2).reshape(b, s, h)
    return o, lse


def dilated_mixer(q, k, v, bias_table):
    outs, lses = [], []
    for window, dilation in DIL_PATTERNS:
        o, lse = dilated_window_attn(q, k, v, window, dilation, bias_table)
        outs.append(o)
        lses.append(lse)
    w = jax.nn.softmax(jnp.stack(lses), axis=0)
    o = jnp.sum(w[..., None] * jnp.stack(outs), axis=0)
    return o.astype(q.dtype)


def diff_attention(q, k, v, lam, bias_table):
    b, s, h, _, hd = q.shape
    nb = s // BLK
    qb = q.reshape(b, nb, BLK, h, 2, hd).transpose(1, 0, 3, 4, 2, 5)
    kt = k.transpose(0, 2, 3, 1, 4)
    vt = v.transpose(0, 2, 1, 3)
    kpos = jnp.arange(s)
    scale = 1.0 / math.sqrt(hd)

    def block(args):
        n, qblk = args
        qpos = n * BLK + jnp.arange(BLK)
        dist = qpos[:, None] - kpos[None, :]
        logits = jnp.einsum('bhcqd,bhckd->bhcqk', qblk, kt).astype(jnp.float32) * scale
        bias = jnp.moveaxis(bias_table[t5_bucket(jnp.maximum(dist, 0))], -1, 0)
        logits = jnp.where(dist >= 0, logits + bias[None, :, None].astype(jnp.float32), NEG)
        p = jax.nn.softmax(logits, axis=-1)
        a = p[:, :, 0] - lam * p[:, :, 1]
        return jnp.einsum('bhqk,bhkd->bhqd', a.astype(vt.dtype), vt)

    out = lax.map(block, (jnp.arange(nb), qb))
    return out.transpose(1, 0, 3, 2, 4).reshape(b, s, h, 2 * hd)


def conv_module(u, conv_w, conv_b, ln_g, ln_b):
    u1, u2 = jnp.split(u, 2, axis=-1)
    u = u1 * jax.nn.sigmoid(u2)
    y = lax.conv_general_dilated(u, conv_w[:, None, :].astype(u.dtype), window_strides=(1,),
                                 padding=[(CONV_K - 1, 0)],
                                 dimension_numbers=('NWC', 'WIO', 'NWC'),
                                 feature_group_count=u.shape[-1]) + conv_b
    return jax.nn.silu(layernorm(y, ln_g, ln_b))


def token_mixer(h, l, rel_bias, w_in, qk_gain, lambda_vec, subln_g, conv_w, conv_b,
                conv_ln_g, conv_ln_b, w_branch, w_gate, b_gate, w_out):
    b, s, d = h.shape
    proj = h @ w_in
    qa, ka, va, qb, kb, vb, u = jnp.split(
        proj, [A_W, 2 * A_W, 3 * A_W, 3 * A_W + B_W, 3 * A_W + 2 * B_W, 3 * A_W + 3 * B_W], axis=-1)
    qa = rmsnorm(qa.reshape(b, s, HA, HEAD_DIM), qk_gain[0])
    ka = rmsnorm(ka.reshape(b, s, HA, HEAD_DIM), qk_gain[1])
    va = va.reshape(b, s, HA, HEAD_DIM)
    y_a = dilated_mixer(qa, ka, va, rel_bias[:, :HA]).reshape(b, s, A_W)
    lam_init = 0.8 - 0.6 * math.exp(-0.3 * l)
    lv = lambda_vec.astype(jnp.float32)
    lam = jnp.exp(jnp.sum(lv[0] * lv[1])) - jnp.exp(jnp.sum(lv[2] * lv[3])) + lam_init
    qb = rmsnorm(qb.reshape(b, s, HB, 2, HEAD_DIM), qk_gain[2:4])
    kb = rmsnorm(kb.reshape(b, s, HB, 2, HEAD_DIM), qk_gain[4:6])
    vb = vb.reshape(b, s, HB, 2 * HEAD_DIM)
    ob = diff_attention(qb, kb, vb, lam, rel_bias[:, HA:])
    y_b = (rmsnorm(ob, subln_g) * (1.0 - lam_init)).reshape(b, s, B_W)
    y_c = conv_module(u, conv_w, conv_b, conv_ln_g, conv_ln_b)
    ys = jnp.einsum('gbsm,gmd->bsgd', jnp.stack([y_a, y_b, y_c]), w_branch)
    gates = jax.nn.sigmoid(h @ w_gate + b_gate).reshape(b, s, N_BRANCH, d)
    return jnp.sum(gates * ys, axis=2) @ w_out


def setup_inputs(seed: int = 0) -> dict:
    key = jax.random.key(seed)
    ks = jax.random.split(key, 20)

    def nrm(k, shape, scale):
        return jax.random.normal(k, shape, jnp.float32) * scale

    D = D_MODEL
    return {
        "x": nrm(ks[0], (BATCH, SEQ, D), 1.0),
        "c": nrm(ks[1], (BATCH, D), 1.0),
        "rel_bias": nrm(ks[2], (N_BUCKETS, HA + HB), 0.2),
        "w_ada": nrm(ks[3], (DEPTH, D, 9 * D), 0.5 * D ** -0.5),
        "b_ada": nrm(ks[4], (DEPTH, 9 * D), 0.02),
        "norm_g": 1.0 + nrm(ks[5], (DEPTH, 3, D), 0.02),
        "w_ffn_in": nrm(ks[6], (DEPTH, 2, D, 2 * D_FF), D ** -0.5),
        "w_ffn_out": nrm(ks[7], (DEPTH, 2, D_FF, D), D_FF ** -0.5),
        "w_in": nrm(ks[8], (DEPTH, D, IN_W), D ** -0.5),
        "qk_gain": 1.0 + nrm(ks[9], (DEPTH, 6, HEAD_DIM), 0.02),
        "lambda_vec": nrm(ks[10], (DEPTH, 4, HEAD_DIM), 0.1),
        "subln_g": 1.0 + nrm(ks[11], (DEPTH, 2 * HEAD_DIM), 0.02),
        "conv_w": nrm(ks[12], (DEPTH, CONV_K, C_CONV), CONV_K ** -0.5),
        "conv_b": nrm(ks[13], (DEPTH, C_CONV), 0.02),
        "conv_ln_g": 1.0 + nrm(ks[14], (DEPTH, C_CONV), 0.02),
        "conv_ln_b": nrm(ks[15], (DEPTH, C_CONV), 0.02),
        "w_branch": nrm(ks[16], (DEPTH, N_BRANCH, MIX_W, D), MIX_W ** -0.5),
        "w_gate": nrm(ks[17], (DEPTH, D, N_BRANCH * D), D ** -0.5),
        "b_gate": nrm(ks[18], (DEPTH, N_BRANCH * D), 0.02),
        "w_out": nrm(ks[19], (DEPTH, D, D), D ** -0.5),
    }


def reference(x, c, rel_bias, w_ada, b_ada, norm_g, w_ffn_in, w_ffn_out, w_in, qk_gain,
              lambda_vec, subln_g, conv_w, conv_b, conv_ln_g, conv_ln_b, w_branch, w_gate,
              b_gate, w_out):
    b, s, d = x.shape
    for l in range(DEPTH):
        mod = (jnp.einsum('bd,de->be', jax.nn.silu(c), w_ada[l]) + b_ada[l]).reshape(b, 9, d)
        h = modulate(rmsnorm(x, norm_g[l, 0]), mod[:, 0], mod[:, 1])
        x = x + 0.5 * mod[:, 2][:, None] * swiglu(h, w_ffn_in[l, 0], w_ffn_out[l, 0])
        h = modulate(rmsnorm(x, norm_g[l, 1]), mod[:, 3], mod[:, 4])
        y = token_mixer(h, l, rel_bias, w_in[l], qk_gain[l], lambda_vec[l], subln_g[l],
                        conv_w[l], conv_b[l], conv_ln_g[l], conv_ln_b[l], w_branch[l],
                        w_gate[l], b_gate[l], w_out[l])
        x = x + mod[:, 5][:, None] * y
        h = modulate(rmsnorm(x, norm_g[l, 2]), mod[:, 6], mod[:, 7])
        x = x + 0.5 * mod[:, 8][:, None] * swiglu(h, w_ffn_in[l, 1], w_ffn_out[l, 1])
    return x
```

```cpp
#include <hip/hip_runtime.h>
#include <hip/hip_cooperative_groups.h>
#include <cstdint>
#include <cstdio>
namespace cg = cooperative_groups;

#define LAS __attribute__((address_space(3)))
typedef unsigned short bf16_t;
typedef short bf16x8 __attribute__((ext_vector_type(8)));
typedef short s16x4 __attribute__((ext_vector_type(4)));
typedef float f32x2 __attribute__((ext_vector_type(2)));
typedef float f32x4 __attribute__((ext_vector_type(4)));
typedef float f32x16 __attribute__((ext_vector_type(16)));
typedef unsigned u32x2 __attribute__((ext_vector_type(2)));
typedef unsigned u32x4 __attribute__((ext_vector_type(4)));
typedef __bf16 bf16x2_t __attribute__((ext_vector_type(2)));

constexpr int BATCH = 4, SEQ = 4096, DM = 1024, M = BATCH * SEQ, DEPTH = 2;
constexpr int DFF = 2816, NUP = 2 * DFF;
constexpr int PROJ_W = 3584;
constexpr int GATE_W = 3072, Y_W = 1536, NIN = 7168;
constexpr int C_QA = 0, C_KA = 512, C_VA = 1024, C_QB = 1536, C_KB = 2048, C_VB = 2560, C_U = 3072;
constexpr float LOG2E = 1.4426950408889634f;
constexpr float QSCALE = 0.125f * LOG2E;
constexpr float NEGBIG = -1e30f;
constexpr float EPS = 1e-6f;

constexpr size_t MiB = 1u << 20;
constexpr size_t WS_CTL = 0;
constexpr size_t WS_MOD = 1 * MiB;
constexpr size_t WS_TBLA = WS_MOD + 512 * 1024;
constexpr size_t WS_TBLB = WS_TBLA + 32 * 1024;
constexpr size_t WS_LAM = WS_TBLB + 128 * 1024;
constexpr size_t WS_W = 2 * MiB;
constexpr size_t W_UP0 = WS_W, W_DN0 = W_UP0 + (size_t)NUP * DM * 2, W_UP1 = W_DN0 + (size_t)DM * DFF * 2, W_DN1 = W_UP1 + (size_t)NUP * DM * 2;
constexpr size_t W_IN = W_DN1 + (size_t)DM * DFF * 2, W_BR = W_IN + (size_t)NIN * DM * 2, W_OUT = W_BR + (size_t)3 * DM * 512 * 2;
constexpr size_t WS_H = 54 * MiB;
constexpr size_t WS_PROJ = 86 * MiB;
constexpr size_t WS_GATES = 198 * MiB;
constexpr size_t WS_Y = 294 * MiB;
constexpr size_t WS_LSE = 342 * MiB;
constexpr size_t WS_END = 344 * MiB;
static_assert(W_OUT + (size_t)DM * DM * 2 <= WS_H, "weights fit");

constexpr int LDS_BYTES = 147456;
constexpr int NTHREADS = 512;

struct Params { const float* in[20]; float* out; unsigned char* ws; int dbg; int pad; };
enum { I_X = 0, I_C, I_RELB, I_WADA, I_BADA, I_NORMG, I_WFFIN, I_WFFOUT, I_WIN, I_QKG, I_LAMV, I_SUBLN, I_CONVW, I_CONVB, I_CLNG, I_CLNB, I_WBR, I_WGATE, I_BGATE, I_WOUT };

__device__ __forceinline__ unsigned pk2(float lo, float hi) { f32x2 v = {lo, hi}; bf16x2_t b = __builtin_convertvector(v, bf16x2_t); return __builtin_bit_cast(unsigned, b); }
__device__ __forceinline__ float bf_lo(unsigned w) { return __uint_as_float(w << 16); }
__device__ __forceinline__ float bf_hi(unsigned w) { return __uint_as_float(w & 0xffff0000u); }
__device__ __forceinline__ float shx(float v, int m, int lane) { return __int_as_float(__builtin_amdgcn_ds_bpermute((lane ^ m) << 2, __float_as_int(v))); }
__device__ __forceinline__ float wave_sum(float v, int lane) {
#pragma unroll
    for (int o = 1; o < 64; o <<= 1) v += shx(v, o, lane);
    return v;
}
__device__ __forceinline__ float fast_exp2(float x) { return __builtin_amdgcn_exp2f(x); }
__device__ __forceinline__ float sigmoidf_(float x) { return __builtin_amdgcn_rcpf(1.0f + fast_exp2(-x * LOG2E)); }
__device__ __forceinline__ float siluf_(float x) { return x * sigmoidf_(x); }
__device__ __forceinline__ int crow(int r, int hi) { return (r & 3) + 8 * (r >> 2) + 4 * hi; }
__device__ __forceinline__ int t5_bucket(int d) {
    if (d < 16) return d;
    const int thr[15] = {22, 30, 40, 54, 73, 99, 134, 182, 246, 332, 450, 609, 825, 1117, 1513};
    int b = 16;
#pragma unroll
    for (int i = 0; i < 15; ++i) b += (d >= thr[i]) ? 1 : 0;
    return b;
}

namespace pg8 {
constexpr int BM = 256, BK = 64, HALF = 128, HTB = HALF * BK * 2, NXCD = 8, WGM = 8;
__host__ __device__ __forceinline__ int lds_byte(int r, int c) { const int st = (r >> 4) * 2 + (c >> 5), rr = r & 15, cc = c & 31, ob = rr * 64 + cc * 2; return st * 1024 + (ob ^ (((ob >> 9) & 1) << 5)); }
__host__ __device__ __forceinline__ void stage_rc(int b, int& R, int& C) { const int st = b / 1024, sb = b % 1024, swz = sb ^ (((sb >> 9) & 1) << 5); R = (st >> 1) * 16 + swz / 64; C = (st & 1) * 32 + (swz % 64) / 2; }
__host__ __device__ __forceinline__ int perm32(int rho) { const int n = rho >> 4, i = rho & 15; return 8 * (i >> 2) + 4 * n + (i & 3); }

struct Unit { int pm, pn, z; };
struct Gemm { const bf16_t* A; const bf16_t* Bt; int lda, ldb, K; long zA, zB; };

struct TileOrder {
    int nM, nN, nwg, G, c, zn;
    __device__ void init(int Mrows, int N, int G_, int c_, int zn_) { nM = Mrows / BM; nN = N / BM; nwg = nM * nN; G = G_; c = c_; zn = zn_; }
    __device__ bool next(int i, Unit& u) const {
        const int ti = i / zn; u.z = i - ti * zn;
        const long L = (long)ti * G + c; if (L >= nwg) return false;
        int wgid = (int)L; { const int q = nwg / NXCD, r = nwg % NXCD, xcd = wgid % NXCD, off = wgid / NXCD; wgid = (xcd < r ? xcd * (q + 1) : r * (q + 1) + (xcd - r) * q) + off; }
        const int nig = WGM * nN, gid = wgid / nig, fm = gid * WGM, gsz = (nM - fm) < WGM ? (nM - fm) : WGM;
        u.pm = fm + ((wgid % nig) % gsz); u.pn = (wgid % nig) / gsz; return true;
    }
};

template <class Epi>
__device__ __forceinline__ void gemm_phase(LAS unsigned char* lds, const Gemm g, const TileOrder& S, const Epi& E) {
    int tid = threadIdx.x; asm volatile("" : "+v"(tid));
    const int wid = __builtin_amdgcn_readfirstlane(tid >> 6), lane = tid & 63, wr = wid >> 2, wc = wid & 3, fr = lane & 15, fq = lane >> 4;
    const int K = g.K, nt = K / BK;
    unsigned voffA[2], voffB[2];
#pragma unroll
    for (int i = 0; i < 2; ++i) { int R, C; stage_rc(tid * 16 + i * 8192, R, C); const int Rb = Epi::PERM ? ((R & ~31) + perm32(R & 31)) : R;
        voffA[i] = (unsigned)(R * g.lda + C) * 2u; voffB[i] = (unsigned)(Rb * g.ldb + C) * 2u; }
    const size_t kstep = (size_t)(BK * 2);
    const size_t hstepA = (size_t)HALF * g.lda * 2, hstepB = (size_t)HALF * g.ldb * 2;
    const size_t tstepA = 2 * hstepA, tstepB = 2 * hstepB;
    const unsigned ldsw = (unsigned)wid * 1024u;
    const int aoff = lds_byte(wr * 64 + fr, fq * 8), boff = lds_byte(wc * 32 + fr, fq * 8);
#define PG8_SA(b, h) (((b) * 2 + (h)) * HTB)
#define PG8_SB(b, h) ((4 + (b) * 2 + (h)) * HTB)
#define PG8_STAGE(bufoff, gbase, voff) do { _Pragma("unroll") for (int _i = 0; _i < 2; ++_i) \
        __builtin_amdgcn_global_load_lds((const unsigned*)((const char*)(gbase) + (voff)[_i]), (LAS unsigned*)(lds + (bufoff) + ldsw + _i * 8192), 16, 0, 0); } while (0)
#define PG8_LDA(dst, b, h) do { _Pragma("unroll") for (int m = 0; m < 4; ++m) _Pragma("unroll") for (int k = 0; k < 2; ++k) dst[m][k] = *(const LAS bf16x8*)(lds + PG8_SA(b, h) + aoff + m * 2048 + k * 1024); } while (0)
#define PG8_LDB(dst, b, h) do { _Pragma("unroll") for (int n = 0; n < 2; ++n) _Pragma("unroll") for (int k = 0; k < 2; ++k) dst[n][k] = *(const LAS bf16x8*)(lds + PG8_SB(b, h) + boff + n * 2048 + k * 1024); } while (0)
#define PG8_MMA(ai, bj, At, Bt) do { __builtin_amdgcn_s_setprio(1); _Pragma("unroll") for (int m = 0; m < 4; ++m) _Pragma("unroll") for (int n = 0; n < 2; ++n) _Pragma("unroll") for (int k = 0; k < 2; ++k) \
        acc[ai][bj][m][n] = __builtin_amdgcn_mfma_f32_16x16x32_bf16(Bt[n][k], At[m][k], acc[ai][bj][m][n], 0, 0, 0); __builtin_amdgcn_s_setprio(0); } while (0)
#define PG8_WAIT_V(n) asm volatile("s_waitcnt vmcnt(" #n ")" ::: "memory")
#define PG8_WAIT_L(n) asm volatile("s_waitcnt lgkmcnt(" #n ")" ::: "memory")
#define PG8_BAR __builtin_amdgcn_s_barrier()
#define PG8_SCHED __builtin_amdgcn_sched_barrier(0)
    Unit cur, nxt; int ui = 0;
    if (!S.next(0, cur)) return;
    f32x4 acc[2][2][4][2];
#pragma unroll
    for (int a = 0; a < 2; ++a)
#pragma unroll
        for (int b = 0; b < 2; ++b)
#pragma unroll
            for (int m = 0; m < 4; ++m)
#pragma unroll
                for (int n = 0; n < 2; ++n) acc[a][b][m][n] = (f32x4){0.f, 0.f, 0.f, 0.f};
    bf16x8 At[4][2], B0[2][2], B1[2][2];
    const char* cA = (const char*)g.A + (size_t)cur.pm * tstepA + (size_t)cur.z * g.zA * 2; const char* cB = (const char*)g.Bt + (size_t)cur.pn * tstepB + (size_t)cur.z * g.zB * 2;
    PG8_STAGE(PG8_SB(0, 0), cB, voffB); PG8_STAGE(PG8_SB(0, 1), cB + hstepB, voffB); PG8_STAGE(PG8_SA(0, 0), cA, voffA); PG8_STAGE(PG8_SA(0, 1), cA + hstepA, voffA);
    if (wr == 1) PG8_BAR;
    PG8_WAIT_V(2); PG8_BAR;
    PG8_STAGE(PG8_SB(1, 0), cB + kstep, voffB); PG8_STAGE(PG8_SA(1, 0), cA + kstep, voffA); PG8_STAGE(PG8_SB(1, 1), cB + hstepB + kstep, voffB);
    PG8_WAIT_V(6); PG8_BAR;
    for (;;) {
        const bool has_next = S.next(ui + 1, nxt);
        const char* nA = has_next ? (const char*)g.A + (size_t)nxt.pm * tstepA + (size_t)nxt.z * g.zA * 2 : cA; const char* nB = has_next ? (const char*)g.Bt + (size_t)nxt.pn * tstepB + (size_t)nxt.z * g.zB * 2 : cB;
        for (int t = 0; t < nt; t += 2) {
            const bool last = (t == nt - 2);
            const char* a1 = cA + (size_t)(t + 1) * kstep;
            const char* a2 = last ? nA : cA + (size_t)(t + 2) * kstep; const char* b2 = last ? nB : cB + (size_t)(t + 2) * kstep;
            const char* a3 = a2 + kstep; const char* b3 = b2 + kstep;
            PG8_LDB(B0, 0, 0); PG8_LDB(B1, 0, 1); PG8_SCHED; PG8_LDA(At, 0, 0); PG8_STAGE(PG8_SA(1, 1), a1 + hstepA, voffA);
            PG8_WAIT_V(8); PG8_WAIT_L(0); PG8_BAR; PG8_MMA(0, 0, At, B0); PG8_MMA(0, 1, At, B1); PG8_BAR; PG8_SCHED;
            PG8_LDA(At, 0, 1); PG8_STAGE(PG8_SB(0, 0), b2, voffB); PG8_STAGE(PG8_SB(0, 1), b2 + hstepB, voffB); PG8_STAGE(PG8_SA(0, 0), a2, voffA);
            PG8_WAIT_V(8); PG8_WAIT_L(0); PG8_BAR; PG8_MMA(1, 0, At, B0); PG8_MMA(1, 1, At, B1); PG8_BAR; PG8_SCHED;
            PG8_LDB(B0, 1, 0); PG8_LDB(B1, 1, 1); PG8_SCHED; PG8_LDA(At, 1, 0); PG8_STAGE(PG8_SA(0, 1), a2 + hstepA, voffA);
            PG8_WAIT_V(8); PG8_WAIT_L(0); PG8_BAR; PG8_MMA(0, 0, At, B0); PG8_MMA(0, 1, At, B1); PG8_BAR; PG8_SCHED;
            PG8_LDA(At, 1, 1); PG8_STAGE(PG8_SB(1, 0), b3, voffB); PG8_STAGE(PG8_SB(1, 1), b3 + hstepB, voffB); PG8_STAGE(PG8_SA(1, 0), a3, voffA);
            PG8_WAIT_V(8); PG8_WAIT_L(0); PG8_BAR; PG8_MMA(1, 0, At, B0); PG8_MMA(1, 1, At, B1); PG8_BAR; PG8_SCHED;
        }
        if (wr == 0) PG8_BAR;
        E(acc, cur, wr, wc, fr, fq);
        if (!has_next) break;
#pragma unroll
        for (int a = 0; a < 2; ++a)
#pragma unroll
            for (int b = 0; b < 2; ++b)
#pragma unroll
                for (int m = 0; m < 4; ++m)
#pragma unroll
                    for (int n = 0; n < 2; ++n) acc[a][b][m][n] = (f32x4){0.f, 0.f, 0.f, 0.f};
        cur = nxt; cA = nA; cB = nB; ++ui;
        if (wr == 1) PG8_BAR;
    }
    PG8_WAIT_V(0);
    PG8_BAR;
#undef PG8_SA
#undef PG8_SB
#undef PG8_STAGE
#undef PG8_LDA
#undef PG8_LDB
#undef PG8_MMA
#undef PG8_WAIT_V
#undef PG8_WAIT_L
#undef PG8_BAR
#undef PG8_SCHED
}

__device__ __forceinline__ u32x4 pack8(const f32x4 a, const f32x4 b) { u32x4 w; w.x = pk2(a[0], a[1]); w.y = pk2(a[2], a[3]); w.z = pk2(b[0], b[1]); w.w = pk2(b[2], b[3]); return w; }

struct EpiSwiGLU {
    static constexpr bool PERM = true;
    bf16_t* O;
    __device__ __forceinline__ void operator()(const f32x4 (&acc)[2][2][4][2], const Unit& u, int wr, int wc, int fr, int fq) const {
        const int row0 = u.pm * BM + wr * 64 + fr, col0 = u.pn * HALF + wc * 32 + 8 * fq;
#pragma unroll
        for (int ai = 0; ai < 2; ++ai)
#pragma unroll
            for (int m = 0; m < 4; ++m) {
                f32x4 h0, h1;
#pragma unroll
                for (int i = 0; i < 4; ++i) { h0[i] = siluf_(acc[ai][0][m][0][i]) * acc[ai][1][m][0][i]; h1[i] = siluf_(acc[ai][0][m][1][i]) * acc[ai][1][m][1][i]; }
                *(u32x4*)(O + (size_t)(row0 + ai * HALF + m * 16) * DFF + col0) = pack8(h0, h1);
            }
    }
};
struct EpiResidual {
    static constexpr bool PERM = false;
    float* out; const float* gvec; float coef;
    __device__ __forceinline__ void operator()(const f32x4 (&acc)[2][2][4][2], const Unit& u, int wr, int wc, int fr, int fq) const {
        const int row0 = u.pm * BM + wr * 64 + fr, col0 = u.pn * BM + wc * 32 + 4 * fq; const int b = u.pm >> 4;
        f32x4 gv[2][2];
#pragma unroll
        for (int bj = 0; bj < 2; ++bj)
#pragma unroll
            for (int n = 0; n < 2; ++n) gv[bj][n] = *(const f32x4*)(gvec + (size_t)b * 9216 + col0 + bj * HALF + n * 16) * coef;
#pragma unroll
        for (int ai = 0; ai < 2; ++ai)
#pragma unroll
            for (int m = 0; m < 4; ++m) { float* rowp = out + (size_t)(row0 + ai * HALF + m * 16) * DM + col0;
#pragma unroll
                for (int bj = 0; bj < 2; ++bj)
#pragma unroll
                    for (int n = 0; n < 2; ++n) { float* p = rowp + bj * HALF + n * 16; *(f32x4*)p = *(const f32x4*)p + gv[bj][n] * acc[ai][bj][m][n]; } }
    }
};
struct EpiInGate {
    static constexpr bool PERM = true;
    bf16_t* proj; bf16_t* gates; const float* bgate;
    __device__ __forceinline__ void operator()(const f32x4 (&acc)[2][2][4][2], const Unit& u, int wr, int wc, int fr, int fq) const {
        const int row0 = u.pm * BM + wr * 64 + fr; const int cw = wc * 32 + 8 * fq;
        if (u.pn < 12) {
#pragma unroll
            for (int ai = 0; ai < 2; ++ai)
#pragma unroll
                for (int m = 0; m < 4; ++m) { bf16_t* rp = proj + (size_t)(row0 + ai * HALF + m * 16) * PROJ_W + u.pn * BM + cw;
#pragma unroll
                    for (int bj = 0; bj < 2; ++bj) *(u32x4*)(rp + bj * HALF) = pack8(acc[ai][bj][m][0], acc[ai][bj][m][1]); }
        } else if (u.pn < 16) {
#pragma unroll
            for (int ai = 0; ai < 2; ++ai)
#pragma unroll
                for (int m = 0; m < 4; ++m) { f32x4 h0, h1;
#pragma unroll
                    for (int i = 0; i < 4; ++i) { h0[i] = acc[ai][0][m][0][i] * sigmoidf_(acc[ai][1][m][0][i]); h1[i] = acc[ai][0][m][1][i] * sigmoidf_(acc[ai][1][m][1][i]); }
                    *(u32x4*)(proj + (size_t)(row0 + ai * HALF + m * 16) * PROJ_W + C_U + (u.pn - 12) * HALF + cw) = pack8(h0, h1); }
        } else {
            const int cb = (u.pn - 16) * BM + cw;
            f32x4 bv[2][2];
#pragma unroll
            for (int bj = 0; bj < 2; ++bj) { bv[bj][0] = *(const f32x4*)(bgate + cb + bj * HALF); bv[bj][1] = *(const f32x4*)(bgate + cb + bj * HALF + 4); }
#pragma unroll
            for (int ai = 0; ai < 2; ++ai)
#pragma unroll
                for (int m = 0; m < 4; ++m) { bf16_t* rp = gates + (size_t)(row0 + ai * HALF + m * 16) * GATE_W + cb;
#pragma unroll
                    for (int bj = 0; bj < 2; ++bj) { f32x4 h0, h1;
#pragma unroll
                        for (int i = 0; i < 4; ++i) { h0[i] = sigmoidf_(acc[ai][bj][m][0][i] + bv[bj][0][i]); h1[i] = sigmoidf_(acc[ai][bj][m][1][i] + bv[bj][1][i]); }
                        *(u32x4*)(rp + bj * HALF) = pack8(h0, h1); } }
        }
    }
};
struct EpiBranch {
    static constexpr bool PERM = true;
    const bf16_t* gates; float* tmp; bf16_t* merged;
    __device__ __forceinline__ void operator()(const f32x4 (&acc)[2][2][4][2], const Unit& u, int wr, int wc, int fr, int fq) const {
        const int row0 = u.pm * BM + wr * 64 + fr; const int cb = u.pn * BM + wc * 32 + 8 * fq; const int z = u.z;
#pragma unroll
        for (int ai = 0; ai < 2; ++ai)
#pragma unroll
            for (int m = 0; m < 4; ++m) { const size_t row = (size_t)(row0 + ai * HALF + m * 16);
#pragma unroll
                for (int bj = 0; bj < 2; ++bj) {
                    const u32x4 gw = *(const u32x4*)(gates + row * GATE_W + z * 1024 + cb + bj * HALF);
                    f32x4 t0, t1;
                    t0[0] = bf_lo(gw.x) * acc[ai][bj][m][0][0]; t0[1] = bf_hi(gw.x) * acc[ai][bj][m][0][1]; t0[2] = bf_lo(gw.y) * acc[ai][bj][m][0][2]; t0[3] = bf_hi(gw.y) * acc[ai][bj][m][0][3];
                    t1[0] = bf_lo(gw.z) * acc[ai][bj][m][1][0]; t1[1] = bf_hi(gw.z) * acc[ai][bj][m][1][1]; t1[2] = bf_lo(gw.w) * acc[ai][bj][m][1][2]; t1[3] = bf_hi(gw.w) * acc[ai][bj][m][1][3];
                    float* tp = tmp + row * DM + cb + bj * HALF;
                    if (z > 0) { t0 += *(const f32x4*)tp; t1 += *(const f32x4*)(tp + 4); }
                    if (z < 2) { *(f32x4*)tp = t0; *(f32x4*)(tp + 4) = t1; }
                    else *(u32x4*)(merged + row * DM + cb + bj * HALF) = pack8(t0, t1);
                } }
    }
};
}

struct Ctx {
    LAS unsigned char* lds;
    int tid, lane, wave, G, vcu, bx;
    const float* const* in;
    float* out; unsigned char* ws;
};
#define WSP(T, off) ((T*)(C.ws + (off)))
__device__ __forceinline__ Ctx rectx(const Ctx& C0) { Ctx C = C0; int t = threadIdx.x; asm volatile("" : "+v"(t)); C.tid = t; C.lane = t & 63; C.wave = __builtin_amdgcn_readfirstlane(t >> 6);
    int z = 0; asm volatile("" : "+s"(z)); C.G += z; C.bx += z; C.vcu += z; C.ws += z; C.out += z; C.in += z; C.lds += z; return C; }

__device__ __forceinline__ void transpose_item(const float* W, int ldw, int srccol0, int k0, bf16_t* WT, int K, int dstrow0, LAS float* scr, int lane) {
#pragma unroll 8
    for (int i = 0; i < 32; ++i) { const int kk = 2 * i + (lane >> 5); scr[kk * 33 + (lane & 31)] = W[(size_t)(k0 + kk) * ldw + srccol0 + (lane & 31)]; }
    asm volatile("s_waitcnt lgkmcnt(0)" ::: "memory");
    const int c = lane & 7;
#pragma unroll
    for (int j = 0; j < 4; ++j) { const int n = (lane >> 3) + 8 * j; const LAS float* s = scr + (8 * c) * 33 + n;
        u32x4 o; o.x = pk2(s[0 * 33], s[1 * 33]); o.y = pk2(s[2 * 33], s[3 * 33]); o.z = pk2(s[4 * 33], s[5 * 33]); o.w = pk2(s[6 * 33], s[7 * 33]);
        *(u32x4*)(WT + (size_t)(dstrow0 + n) * K + k0 + 8 * c) = o; }
    asm volatile("s_waitcnt lgkmcnt(0)" ::: "memory");
}
__device__ __forceinline__ int up_srccol(int n0) { const int tile = n0 >> 8, half = (n0 >> 7) & 1, j = n0 & 127; return half * DFF + tile * 128 + j; }
__device__ __forceinline__ int win_srccol(int n0) { if (n0 < 3072) return n0; const int t = (n0 - 3072) >> 8, half = ((n0 - 3072) >> 7) & 1, j = n0 & 127; return 3072 + half * 512 + t * 128 + j; }

__device__ __forceinline__ void convert_weights(const Ctx& C0, int l) {
    const Ctx C = rectx(C0);
    LAS float* scr = (LAS float*)(C.lds + C.wave * 16384);
    const int gw = C.vcu * 8 + C.wave, NGW = C.G * 8;
    constexpr int I_UP = (DM / 64) * (NUP / 32), I_DN = (DFF / 64) * (DM / 32), I_INA = (DM / 64) * (4096 / 32), I_INB = (DM / 64) * (3072 / 32), I_BRN = (512 / 64) * (DM / 32), I_OUTN = (DM / 64) * (DM / 32);
    constexpr int NITEMS = 2 * I_UP + 2 * I_DN + I_INA + I_INB + 3 * I_BRN + I_OUTN;
    const float* wffin = C.in[I_WFFIN] + (size_t)l * 2 * DM * NUP;
    const float* wffout = C.in[I_WFFOUT] + (size_t)l * 2 * DFF * DM;
    const float* win = C.in[I_WIN] + (size_t)l * DM * 4096;
    const float* wgate = C.in[I_WGATE] + (size_t)l * DM * 3072;
    const float* wbr = C.in[I_WBR] + (size_t)l * 3 * 512 * DM;
    const float* wout = C.in[I_WOUT] + (size_t)l * DM * DM;
    for (int it = gw; it < NITEMS; it += NGW) {
        int r = it;
        if (r < 2 * I_UP) { const int f = r / I_UP; r -= f * I_UP; const int nblk = NUP / 32, kb = r / nblk, nb = r % nblk;
            transpose_item(wffin + (size_t)f * DM * NUP, NUP, up_srccol(nb * 32), kb * 64, WSP(bf16_t, f ? W_UP1 : W_UP0), DM, nb * 32, scr, C.lane); continue; }
        r -= 2 * I_UP;
        if (r < 2 * I_DN) { const int f = r / I_DN; r -= f * I_DN; const int nblk = DM / 32, kb = r / nblk, nb = r % nblk;
            transpose_item(wffout + (size_t)f * DFF * DM, DM, nb * 32, kb * 64, WSP(bf16_t, f ? W_DN1 : W_DN0), DFF, nb * 32, scr, C.lane); continue; }
        r -= 2 * I_DN;
        if (r < I_INA) { const int nblk = 4096 / 32, kb = r / nblk, nb = r % nblk;
            transpose_item(win, 4096, win_srccol(nb * 32), kb * 64, WSP(bf16_t, W_IN), DM, nb * 32, scr, C.lane); continue; }
        r -= I_INA;
        if (r < I_INB) { const int nblk = 3072 / 32, kb = r / nblk, nb = r % nblk;
            transpose_item(wgate, 3072, nb * 32, kb * 64, WSP(bf16_t, W_IN), DM, 4096 + nb * 32, scr, C.lane); continue; }
        r -= I_INB;
        if (r < 3 * I_BRN) { const int gI = r / I_BRN; r -= gI * I_BRN; const int nblk = DM / 32, kb = r / nblk, nb = r % nblk;
            transpose_item(wbr + (size_t)gI * 512 * DM, DM, nb * 32, kb * 64, WSP(bf16_t, W_BR) + (size_t)gI * DM * 512, 512, nb * 32, scr, C.lane); continue; }
        r -= 3 * I_BRN;
        { const int nblk = DM / 32, kb = r / nblk, nb = r % nblk;
            transpose_item(wout, DM, nb * 32, kb * 64, WSP(bf16_t, W_OUT), DM, nb * 32, scr, C.lane); }
    }
}

__device__ __forceinline__ void prologue_misc(const Ctx& C0) {
    const Ctx C = rectx(C0);
    const int gtid = C.bx * NTHREADS + C.tid, NT = C.G * NTHREADS;
    {
        const f32x4* s = (const f32x4*)C.in[I_X]; f32x4* d = (f32x4*)C.out;
        for (int i = gtid; i < M * DM / 4; i += NT) d[i] = s[i];
    }
    {
        const float* relb = C.in[I_RELB];
        float* ta = WSP(float, WS_TBLA); float* tb = WSP(float, WS_TBLB);
        for (int i = gtid; i < 3 * 8 * 192; i += NT) { const int p = i / (8 * 192), h = (i / 192) % 8, idx = i % 192, rel = idx - 32; const int dil = (p == 0) ? 1 : (p == 1 ? 4 : 16);
            ta[i] = (rel >= 0 && rel <= 128) ? relb[t5_bucket(rel * dil) * 12 + h] * LOG2E : NEGBIG; }
        for (int i = gtid; i < 4 * 4224; i += NT) { const int h = i / 4224, dist = (i % 4224) - 128;
            tb[i] = (dist >= 0) ? relb[t5_bucket(dist) * 12 + 8 + h] * LOG2E : NEGBIG; }
        if (gtid < DEPTH) { const float* lv = C.in[I_LAMV] + gtid * 256; float a = 0.f, b = 0.f;
            for (int i = 0; i < 64; ++i) { a += lv[i] * lv[64 + i]; b += lv[128 + i] * lv[192 + i]; }
            const float lam_init = 0.8f - 0.6f * expf(-0.3f * (float)gtid);
            WSP(float, WS_LAM)[gtid] = expf(a) - expf(b) + lam_init; }
    }
    {
        LAS float* sc = (LAS float*)C.lds;
        LAS float* red = (LAS float*)(C.lds + 16384);
        const float* cin = C.in[I_C];
        for (int i = C.tid; i < 4096; i += NTHREADS) sc[i] = siluf_(cin[i]);
        __syncthreads();
        for (int it = C.bx; it < 2 * 144; it += C.G) {
            const int l = it / 144, cb = it % 144; const int e = cb * 64 + C.lane;
            const float* w = C.in[I_WADA] + (size_t)l * DM * 9216 + e;
            float a0 = 0.f, a1 = 0.f, a2 = 0.f, a3 = 0.f; const int d0 = C.wave * 128;
#pragma unroll 8
            for (int d = 0; d < 128; ++d) { const float wv = w[(size_t)(d0 + d) * 9216]; a0 += sc[d0 + d] * wv; a1 += sc[1024 + d0 + d] * wv; a2 += sc[2048 + d0 + d] * wv; a3 += sc[3072 + d0 + d] * wv; }
            red[(C.wave * 4 + 0) * 64 + C.lane] = a0; red[(C.wave * 4 + 1) * 64 + C.lane] = a1; red[(C.wave * 4 + 2) * 64 + C.lane] = a2; red[(C.wave * 4 + 3) * 64 + C.lane] = a3;
            __syncthreads();
            if (C.tid < 256) { const int b = C.tid >> 6, ln = C.tid & 63; float s = 0.f;
#pragma unroll
                for (int w8 = 0; w8 < 8; ++w8) s += red[(w8 * 4 + b) * 64 + ln];
                const int ee = cb * 64 + ln;
                WSP(float, WS_MOD)[((size_t)l * 4 + b) * 9216 + ee] = s + C.in[I_BADA][l * 9216 + ee]; }
            __syncthreads();
        }
    }
}

__device__ __forceinline__ void norm_phase(const Ctx& C0, int l, int which) {
    const Ctx C = rectx(C0);
    const int gw = C.vcu * 8 + C.wave, NGW = C.G * 8;
    const float* g = C.in[I_NORMG] + ((size_t)l * 3 + which) * DM;
    const float* mod = WSP(float, WS_MOD) + (size_t)l * 4 * 9216;
    bf16_t* H = WSP(bf16_t, WS_H);
    for (int row = gw; row < M; row += NGW) {
        const int b = row >> 12;
        const f32x4* xr = (const f32x4*)(C.out + (size_t)row * DM) + C.lane;
        const f32x4* sh = (const f32x4*)(mod + (size_t)b * 9216 + (3 * which) * 1024) + C.lane;
        const f32x4* scl = (const f32x4*)(mod + (size_t)b * 9216 + (3 * which + 1) * 1024) + C.lane;
        const f32x4* gg = (const f32x4*)g + C.lane;
        f32x4 v[4]; float s = 0.f;
#pragma unroll
        for (int j = 0; j < 4; ++j) { v[j] = xr[64 * j]; s += (v[j].x * v[j].x + v[j].y * v[j].y) + (v[j].z * v[j].z + v[j].w * v[j].w); }
        const float rstd = 1.0f / sqrtf(wave_sum(s, C.lane) * (1.0f / DM) + EPS);
        u32x2* o8 = (u32x2*)(H + (size_t)row * DM) + C.lane;
#pragma unroll
        for (int j = 0; j < 4; ++j) { const f32x4 gv = gg[64 * j], sv = scl[64 * j], hv = sh[64 * j];
            f32x4 y = (v[j] * rstd) * gv; y = y * (sv + 1.0f) + hv;
            u32x2 w; w.x = pk2(y.x, y.y); w.y = pk2(y.z, y.w); o8[64 * j] = w; }
    }
}

__device__ __forceinline__ void qknorm_phase(const Ctx& C0, int l) {
    const Ctx C = rectx(C0);
    const int gw = C.vcu * 8 + C.wave, NGW = C.G * 8;
    const float* qkg = C.in[I_QKG] + (size_t)l * 6 * 64;
    bf16_t* proj = WSP(bf16_t, WS_PROJ);
    const int d0 = (C.lane & 7) * 8, grp = C.lane >> 3;
    for (int row = gw; row < M; row += NGW) {
#pragma unroll
        for (int sec = 0; sec < 4; ++sec) {
            const int cbase = (sec == 0) ? C_QA : (sec == 1) ? C_KA : (sec == 2) ? C_QB : C_KB;
            int gi; float sc;
            if (sec == 0) { gi = 0; sc = QSCALE; } else if (sec == 1) { gi = 1; sc = 1.f; } else if (sec == 2) { gi = 2 + (grp & 1); sc = QSCALE; } else { gi = 4 + (grp & 1); sc = 1.f; }
            u32x4* p = (u32x4*)(proj + (size_t)row * PROJ_W + cbase + C.lane * 8);
            const u32x4 w = *p;
            float x[8] = {bf_lo(w.x), bf_hi(w.x), bf_lo(w.y), bf_hi(w.y), bf_lo(w.z), bf_hi(w.z), bf_lo(w.w), bf_hi(w.w)};
            float s = 0.f;
#pragma unroll
            for (int i = 0; i < 8; ++i) s += x[i] * x[i];
            s += shx(s, 1, C.lane); s += shx(s, 2, C.lane); s += shx(s, 4, C.lane);
            const float r = sc / sqrtf(s * (1.0f / 64.0f) + EPS);
            const f32x4 g0 = *(const f32x4*)(qkg + gi * 64 + d0), g1 = *(const f32x4*)(qkg + gi * 64 + d0 + 4);
            u32x4 o; o.x = pk2(x[0] * r * g0.x, x[1] * r * g0.y); o.y = pk2(x[2] * r * g0.z, x[3] * r * g0.w); o.z = pk2(x[4] * r * g1.x, x[5] * r * g1.y); o.w = pk2(x[6] * r * g1.z, x[7] * r * g1.w);
            *p = o;
        }
    }
}

__device__ __forceinline__ void conv_phase(const Ctx& C0, int l) {
    const Ctx C = rectx(C0);
    const bf16_t* proj = WSP(const bf16_t, WS_PROJ); bf16_t* Y = WSP(bf16_t, WS_Y);
    LAS bf16_t* ut = (LAS bf16_t*)C.lds;
    LAS float* yt = (LAS float*)(C.lds + 65536);
    const int c = C.tid;
    float w[31];
#pragma unroll
    for (int j = 0; j < 31; ++j) w[j] = C.in[I_CONVW][((size_t)l * 31 + j) * 512 + c];
    const float cb = C.in[I_CONVB][l * 512 + c];
    const float* lng = C.in[I_CLNG] + l * 512; const float* lnb = C.in[I_CLNB] + l * 512;
    for (int un = C.vcu; un < M / 32; un += C.G) {
        const int row0 = un * 32, t0 = row0 & (SEQ - 1);
        for (int i = C.tid; i < 62 * 64; i += NTHREADS) { const int rr = i >> 6, ch = i & 63; const int t = t0 - 30 + rr;
            u32x4 v = (u32x4){0u, 0u, 0u, 0u};
            if (t >= 0) v = *(const u32x4*)(proj + (size_t)(row0 - 30 + rr) * PROJ_W + C_U + ch * 8);
            *(LAS u32x4*)(ut + rr * 512 + ch * 8) = v; }
        __syncthreads();
#pragma unroll 1
        for (int g8 = 0; g8 < 4; ++g8) {
            float uu[38];
#pragma unroll
            for (int i = 0; i < 38; ++i) uu[i] = __uint_as_float((unsigned)ut[(g8 * 8 + i) * 512 + c] << 16);
#pragma unroll
            for (int i = 0; i < 8; ++i) { float a = cb;
#pragma unroll
                for (int j = 0; j < 31; ++j) a += w[j] * uu[i + j];
                yt[(g8 * 8 + i) * 512 + c] = a; }
        }
        __syncthreads();
#pragma unroll
        for (int rr = 0; rr < 4; ++rr) { const int r = C.wave * 4 + rr; const LAS float* yr = yt + r * 512 + C.lane * 8;
            float x[8]; float s = 0.f;
#pragma unroll
            for (int i = 0; i < 8; ++i) { x[i] = yr[i]; s += x[i]; }
            const float mean = wave_sum(s, C.lane) * (1.0f / 512.0f); float q = 0.f;
#pragma unroll
            for (int i = 0; i < 8; ++i) { x[i] -= mean; q += x[i] * x[i]; }
            const float rstd = 1.0f / sqrtf(wave_sum(q, C.lane) * (1.0f / 512.0f) + EPS);
            float o[8];
#pragma unroll
            for (int i = 0; i < 8; ++i) { const float v = x[i] * rstd * lng[C.lane * 8 + i] + lnb[C.lane * 8 + i]; o[i] = siluf_(v); }
            u32x4 pw; pw.x = pk2(o[0], o[1]); pw.y = pk2(o[2], o[3]); pw.z = pk2(o[4], o[5]); pw.w = pk2(o[6], o[7]);
            *(u32x4*)(Y + (size_t)(row0 + r) * Y_W + 1024 + C.lane * 8) = pw; }
        __syncthreads();
    }
}

__device__ __forceinline__ s16x4 vtr(const LAS unsigned char* p) { return __builtin_bit_cast(s16x4, __builtin_amdgcn_ds_read_tr16_b64_v4i16((LAS s16x4*)p)); }
__device__ __forceinline__ bf16x8 vfrag(const LAS unsigned char* p) { const s16x4 lo = vtr(p), hi = vtr(p + 512); return (bf16x8){lo[0], lo[1], lo[2], lo[3], hi[0], hi[1], hi[2], hi[3]}; }
__device__ __forceinline__ bf16x8 pfrag(const f32x16& p, int s) {
    u32x4 w; w.x = pk2(p[8 * s + 0], p[8 * s + 1]); w.y = pk2(p[8 * s + 2], p[8 * s + 3]); w.z = pk2(p[8 * s + 4], p[8 * s + 5]); w.w = pk2(p[8 * s + 6], p[8 * s + 7]);
    return __builtin_bit_cast(bf16x8, w);
}

__device__ __forceinline__ void dilated_phase(const Ctx& C0) {
    const Ctx C = rectx(C0);
    const bf16_t* proj = WSP(const bf16_t, WS_PROJ);
    LAS unsigned char* Kl = C.lds;
    LAS unsigned char* Vl = C.lds + 49152;
    LAS float* tbl = (LAS float*)(C.lds + 98304);
    const int lane = C.lane, r32 = lane & 31, hi = lane >> 5, w = C.wave;
    const int vlane = ((lane >> 4) & 1) * 32 + (lane & 3) * 8 + (4 * hi + ((lane & 15) >> 2)) * 64;
    for (int uid = C.vcu; uid < 1536; uid += C.G) {
        const int p = uid >> 9, rem = uid & 511, bh = rem >> 4, ru = rem & 15;
        const int dil = (p == 0) ? 1 : (p == 1 ? 4 : 16), nu = 16 / dil, r = ru / nu, u = ru % nu;
        const int b = bh >> 3, h = bh & 7;
        const size_t tokbase = (size_t)b * SEQ;
        if (C.tid < 192) tbl[C.tid] = WSP(const float, WS_TBLA)[(p * 8 + h) * 192 + C.tid];
        u32x4 kreg[6], vreg[6];
#pragma unroll
        for (int i = 0; i < 6; ++i) { const int idx = C.tid + 512 * i;
            { const int chunk = idx / 384, key = idx - chunk * 384; const int sidx = 256 * u - 128 + key;
              kreg[i] = (u32x4){0u, 0u, 0u, 0u};
              if (sidx >= 0) kreg[i] = *(const u32x4*)(proj + (tokbase + (size_t)sidx * dil + r) * PROJ_W + C_KA + h * 64 + chunk * 8); }
            { const int dblk = idx / 1536, rm = idx - dblk * 1536, ks = rm >> 6, k16 = (rm & 63) >> 2, c4 = rm & 3; const int sidx = 256 * u - 128 + ks * 16 + k16;
              vreg[i] = (u32x4){0u, 0u, 0u, 0u};
              if (sidx >= 0) vreg[i] = *(const u32x4*)(proj + (tokbase + (size_t)sidx * dil + r) * PROJ_W + C_VA + h * 64 + dblk * 32 + c4 * 8); }
        }
#pragma unroll
        for (int i = 0; i < 6; ++i) { const int idx = C.tid + 512 * i; *(LAS u32x4*)(Kl + idx * 16) = kreg[i]; *(LAS u32x4*)(Vl + idx * 16) = vreg[i]; }
        const int iq = 32 * w + r32; const size_t tq = tokbase + (size_t)(256 * u + iq) * dil + r;
        bf16x8 qf[4];
#pragma unroll
        for (int d0 = 0; d0 < 4; ++d0) qf[d0] = *(const bf16x8*)(proj + tq * PROJ_W + C_QA + h * 64 + d0 * 16 + hi * 8);
        __syncthreads();
        f32x16 S[5]; float mx = NEGBIG;
#pragma unroll
        for (int s = 0; s < 5; ++s) {
            const bool skip = (u == 0) && (w + s < 4);
            if (!skip) {
                f32x16 a;
#pragma unroll
                for (int rg = 0; rg < 16; ++rg) a[rg] = tbl[(r32 + 5 - 4 * hi) + (128 - 32 * s) + 27 - ((rg & 3) + 8 * (rg >> 2))];
                const int jj0 = 32 * (w + s);
#pragma unroll
                for (int d0 = 0; d0 < 4; ++d0) { const bf16x8 kf = *(const LAS bf16x8*)(Kl + (2 * d0 + hi) * 6144 + (jj0 + r32) * 16);
                    a = __builtin_amdgcn_mfma_f32_32x32x16_bf16(kf, qf[d0], a, 0, 0, 0); }
                S[s] = a;
#pragma unroll
                for (int rg = 0; rg < 16; ++rg) mx = fmaxf(mx, a[rg]);
            } else {
#pragma unroll
                for (int rg = 0; rg < 16; ++rg) S[s][rg] = NEGBIG;
            }
        }
        mx = fmaxf(mx, shx(mx, 32, C.lane));
        float den = 0.f;
#pragma unroll
        for (int s = 0; s < 5; ++s)
#pragma unroll
            for (int rg = 0; rg < 16; ++rg) { const float e = fast_exp2(S[s][rg] - mx); S[s][rg] = e; den += e; }
        den += shx(den, 32, C.lane);
        f32x16 o[2]; o[0] = (f32x16){}; o[1] = (f32x16){};
#pragma unroll
        for (int s = 0; s < 5; ++s) {
            const bool skip = (u == 0) && (w + s < 4);
            if (!skip) {
#pragma unroll
                for (int s16 = 0; s16 < 2; ++s16) { const int ksg = 2 * (w + s) + s16; const bf16x8 pf = pfrag(S[s], s16);
#pragma unroll
                    for (int dblk = 0; dblk < 2; ++dblk) { const bf16x8 vf = vfrag(Vl + dblk * 24576 + ksg * 1024 + vlane);
                        o[dblk] = __builtin_amdgcn_mfma_f32_32x32x16_bf16(vf, pf, o[dblk], 0, 0, 0); } }
            }
        }
        const float rden = 1.0f / den;
        bf16_t* Op; int opitch;
        if (p == 0) { Op = WSP(bf16_t, WS_Y); opitch = Y_W; } else { Op = WSP(bf16_t, WS_H) + (size_t)(p - 1) * M * 512; opitch = 512; }
        bf16_t* orow = Op + tq * opitch + h * 64;
#pragma unroll
        for (int dblk = 0; dblk < 2; ++dblk)
#pragma unroll
            for (int rg = 0; rg < 4; ++rg) { u32x2 wv; wv.x = pk2(o[dblk][4 * rg] * rden, o[dblk][4 * rg + 1] * rden); wv.y = pk2(o[dblk][4 * rg + 2] * rden, o[dblk][4 * rg + 3] * rden);
                *(u32x2*)(orow + 32 * dblk + 8 * rg + 4 * hi) = wv; }
        if (hi == 0) WSP(float, WS_LSE)[((size_t)p * M + tq) * 8 + h] = mx + log2f(den);
        __syncthreads();
    }
}

__device__ __forceinline__ void combine_phase(const Ctx& C0) {
    const Ctx C = rectx(C0);
    const int gtid = C.bx * NTHREADS + C.tid, NT = C.G * NTHREADS;
    bf16_t* Y = WSP(bf16_t, WS_Y); const bf16_t* O1 = WSP(const bf16_t, WS_H); const bf16_t* O2 = O1 + (size_t)M * 512; const float* lse = WSP(const float, WS_LSE);
    for (int i = gtid; i < M * 64; i += NT) { const int row = i >> 6, c8 = i & 63, h = c8 >> 3;
        const float l0 = lse[(size_t)row * 8 + h], l1 = lse[((size_t)M + row) * 8 + h], l2 = lse[((size_t)2 * M + row) * 8 + h];
        const float mx = fmaxf(l0, fmaxf(l1, l2)); float w0 = fast_exp2(l0 - mx), w1 = fast_exp2(l1 - mx), w2 = fast_exp2(l2 - mx); const float rs = 1.0f / (w0 + w1 + w2); w0 *= rs; w1 *= rs; w2 *= rs;
        u32x4* yp = (u32x4*)(Y + (size_t)row * Y_W + c8 * 8);
        const u32x4 a = *yp, b = *(const u32x4*)(O1 + (size_t)row * 512 + c8 * 8), c = *(const u32x4*)(O2 + (size_t)row * 512 + c8 * 8);
        u32x4 o;
        o.x = pk2(w0 * bf_lo(a.x) + w1 * bf_lo(b.x) + w2 * bf_lo(c.x), w0 * bf_hi(a.x) + w1 * bf_hi(b.x) + w2 * bf_hi(c.x));
        o.y = pk2(w0 * bf_lo(a.y) + w1 * bf_lo(b.y) + w2 * bf_lo(c.y), w0 * bf_hi(a.y) + w1 * bf_hi(b.y) + w2 * bf_hi(c.y));
        o.z = pk2(w0 * bf_lo(a.z) + w1 * bf_lo(b.z) + w2 * bf_lo(c.z), w0 * bf_hi(a.z) + w1 * bf_hi(b.z) + w2 * bf_hi(c.z));
        o.w = pk2(w0 * bf_lo(a.w) + w1 * bf_lo(b.w) + w2 * bf_lo(c.w), w0 * bf_hi(a.w) + w1 * bf_hi(b.w) + w2 * bf_hi(c.w));
        *yp = o; }
}

__device__ __forceinline__ void diff_unit(const Ctx& C, int l, int b, int h, int qb) {
    const bf16_t* proj = WSP(const bf16_t, WS_PROJ);
    LAS float* tbl = (LAS float*)(C.lds + 65536);
    const int lane = C.lane, r32 = lane & 31, hi = lane >> 5, w = C.wave, comp = w >> 2, wq = w & 3;
    const int vlane = ((lane >> 4) & 1) * 32 + (lane & 3) * 8 + (4 * hi + ((lane & 15) >> 2)) * 64;
    const size_t tokbase = (size_t)b * SEQ; const int q0 = qb * 128;
    const int nkt = 2 * (qb + 1);
    for (int i = C.tid; i < 4224; i += NTHREADS) tbl[i] = WSP(const float, WS_TBLB)[h * 4224 + i];
    u32x4 kreg[2], vreg[2];
#define DIFF_LOAD(kt) do { _Pragma("unroll") for (int i_ = 0; i_ < 2; ++i_) { const int idx = C.tid + 512 * i_; \
        { const int cp = idx >> 9, chunk = (idx & 511) >> 6, key = idx & 63; kreg[i_] = *(const u32x4*)(proj + (tokbase + (size_t)(kt) * 64 + key) * PROJ_W + C_KB + h * 128 + cp * 64 + chunk * 8); } \
        { const int dblk = idx >> 8, ks = (idx & 255) >> 6, k16 = (idx & 63) >> 2, c4 = idx & 3; vreg[i_] = *(const u32x4*)(proj + (tokbase + (size_t)(kt) * 64 + ks * 16 + k16) * PROJ_W + C_VB + h * 128 + dblk * 32 + c4 * 8); } } } while (0)
#define DIFF_STORE(buf) do { _Pragma("unroll") for (int i_ = 0; i_ < 2; ++i_) { const int idx = C.tid + 512 * i_; \
        *(LAS u32x4*)(C.lds + (buf) * 32768 + idx * 16) = kreg[i_]; *(LAS u32x4*)(C.lds + (buf) * 32768 + 16384 + idx * 16) = vreg[i_]; } } while (0)
    DIFF_LOAD(0);
    const int qrow = q0 + 32 * wq + r32;
    bf16x8 qf[4];
#pragma unroll
    for (int d0 = 0; d0 < 4; ++d0) qf[d0] = *(const bf16x8*)(proj + (tokbase + qrow) * PROJ_W + C_QB + h * 128 + comp * 64 + d0 * 16 + hi * 8);
    DIFF_STORE(0);
    __syncthreads();
    f32x16 o[4]; o[0] = (f32x16){}; o[1] = (f32x16){}; o[2] = (f32x16){}; o[3] = (f32x16){};
    float mrun = NEGBIG, lrun = 0.f;
#pragma unroll 1
    for (int kt = 0; kt < nkt; ++kt) {
        const int buf = kt & 1;
        if (kt + 1 < nkt) DIFF_LOAD(kt + 1);
        const LAS unsigned char* Kc = C.lds + buf * 32768 + comp * 8192;
        const LAS unsigned char* Vc = C.lds + buf * 32768 + 16384;
        f32x16 S0, S1;
        {
            const LAS float* tb1 = tbl + (qrow - 64 * kt + 128 - 4 * hi - 27 - 32);
#pragma unroll
            for (int rg = 0; rg < 16; ++rg) { S0[rg] = tb1[32 + 27 - ((rg & 3) + 8 * (rg >> 2))]; S1[rg] = tb1[27 - ((rg & 3) + 8 * (rg >> 2))]; }
#pragma unroll
            for (int d0 = 0; d0 < 4; ++d0) {
                const bf16x8 k0 = *(const LAS bf16x8*)(Kc + (2 * d0 + hi) * 1024 + r32 * 16);
                const bf16x8 k1 = *(const LAS bf16x8*)(Kc + (2 * d0 + hi) * 1024 + (32 + r32) * 16);
                S0 = __builtin_amdgcn_mfma_f32_32x32x16_bf16(k0, qf[d0], S0, 0, 0, 0);
                S1 = __builtin_amdgcn_mfma_f32_32x32x16_bf16(k1, qf[d0], S1, 0, 0, 0);
            }
        }
        float mx = NEGBIG;
#pragma unroll
        for (int rg = 0; rg < 16; ++rg) mx = fmaxf(mx, fmaxf(S0[rg], S1[rg]));
        mx = fmaxf(mx, shx(mx, 32, C.lane));
        const float mnew = fmaxf(mrun, mx);
        if (__any(mnew > mrun)) {
            const float alpha = fast_exp2(mrun - mnew);
            lrun *= alpha;
#pragma unroll
            for (int d = 0; d < 4; ++d)
#pragma unroll
                for (int rg = 0; rg < 16; ++rg) o[d][rg] *= alpha;
            mrun = mnew;
        }
        float ps = 0.f;
#pragma unroll
        for (int rg = 0; rg < 16; ++rg) { S0[rg] = fast_exp2(S0[rg] - mrun); S1[rg] = fast_exp2(S1[rg] - mrun); ps += S0[rg] + S1[rg]; }
        lrun += ps;
#pragma unroll
        for (int kk = 0; kk < 2; ++kk)
#pragma unroll
            for (int s16 = 0; s16 < 2; ++s16) { const int ksg = 2 * kk + s16; const bf16x8 pf = pfrag(kk ? S1 : S0, s16);
#pragma unroll
                for (int dblk = 0; dblk < 4; ++dblk) { const bf16x8 vf = vfrag(Vc + dblk * 4096 + ksg * 1024 + vlane);
                    o[dblk] = __builtin_amdgcn_mfma_f32_32x32x16_bf16(vf, pf, o[dblk], 0, 0, 0); } }
        if (kt + 1 < nkt) DIFF_STORE(buf ^ 1);
        __syncthreads();
    }
#undef DIFF_LOAD
#undef DIFF_STORE
    lrun += shx(lrun, 32, C.lane);
    const float rl = 1.0f / lrun;
    const float lam = WSP(const float, WS_LAM)[l];
    const float lam_init = 0.8f - 0.6f * expf(-0.3f * (float)l);
    LAS float* ex = (LAS float*)(C.lds + wq * 16384);
    if (comp == 1) {
#pragma unroll
        for (int dblk = 0; dblk < 4; ++dblk)
#pragma unroll
            for (int rg = 0; rg < 16; ++rg) ex[(32 * dblk + crow(rg, hi)) * 32 + r32] = o[dblk][rg] * rl * lam;
    }
    __syncthreads();
    if (comp == 0) {
        float ss = 0.f;
#pragma unroll
        for (int dblk = 0; dblk < 4; ++dblk)
#pragma unroll
            for (int rg = 0; rg < 16; ++rg) { const float v = o[dblk][rg] * rl - ex[(32 * dblk + crow(rg, hi)) * 32 + r32]; o[dblk][rg] = v; ss += v * v; }
        ss += shx(ss, 32, C.lane);
        const float rs = (1.0f - lam_init) / sqrtf(ss * (1.0f / 128.0f) + EPS);
        const float* sg = C.in[I_SUBLN] + l * 128;
        bf16_t* yrow = WSP(bf16_t, WS_Y) + (tokbase + qrow) * Y_W + 512 + h * 128;
#pragma unroll
        for (int dblk = 0; dblk < 4; ++dblk)
#pragma unroll
            for (int rg = 0; rg < 4; ++rg) { const int d = 32 * dblk + 8 * rg + 4 * hi; const f32x4 g = *(const f32x4*)(sg + d);
                u32x2 wv; wv.x = pk2(o[dblk][4 * rg] * rs * g.x, o[dblk][4 * rg + 1] * rs * g.y); wv.y = pk2(o[dblk][4 * rg + 2] * rs * g.z, o[dblk][4 * rg + 3] * rs * g.w);
                *(u32x2*)(yrow + d) = wv; }
    }
    __syncthreads();
}
__device__ __forceinline__ void diff_phase(const Ctx& C0, int l) {
    const Ctx C = rectx(C0);
    for (int pi = C.vcu; pi < 256; pi += C.G) {
        const int bh = pi >> 4, j = pi & 15;
        diff_unit(C, l, bh >> 2, bh & 3, 31 - j);
        diff_unit(C, l, bh >> 2, bh & 3, j);
    }
}

__global__ void __launch_bounds__(NTHREADS, 2) fwd_megakernel(Params P) {
    extern __shared__ __attribute__((aligned(16))) unsigned char lds_raw[];
    cg::grid_group grid = cg::this_grid();
    Ctx CB;
    CB.lds = (LAS unsigned char*)lds_raw;
    CB.tid = 0; CB.lane = 0; CB.wave = 0;
    CB.G = gridDim.x; CB.bx = blockIdx.x; CB.vcu = (CB.G % 8 == 0) ? (CB.bx % 8) * (CB.G / 8) + CB.bx / 8 : CB.bx;
    CB.in = P.in; CB.out = P.out; CB.ws = P.ws;

    constexpr int NSTEP = 14;
#pragma unroll 1
    for (int step = 0; step < DEPTH * NSTEP; ++step) {
        const int l = step / NSTEP, s = step - l * NSTEP;
        const Ctx C = rectx(CB);
        const float* modl = WSP(const float, WS_MOD) + (size_t)l * 4 * 9216;
        switch (s) {
        case 0: if (l == 0) prologue_misc(C); convert_weights(C, l); break;
        case 1: norm_phase(C, l, 0); break;
        case 4: norm_phase(C, l, 1); break;
        case 11: norm_phase(C, l, 2); break;
        case 2: case 12: {
            const int f = (s == 12);
            pg8::Gemm g{WSP(const bf16_t, WS_H), WSP(const bf16_t, f ? W_UP1 : W_UP0), DM, DM, DM, 0, 0};
            pg8::TileOrder S; S.init(M, NUP, C.G, C.bx, 1);
            pg8::EpiSwiGLU E{WSP(bf16_t, WS_PROJ)};
            pg8::gemm_phase(C.lds, g, S, E);
        } break;
        case 3: case 13: {
            const int f = (s == 13);
            pg8::Gemm g{WSP(const bf16_t, WS_PROJ), WSP(const bf16_t, f ? W_DN1 : W_DN0), DFF, DFF, DFF, 0, 0};
            pg8::TileOrder S; S.init(M, DM, C.G, C.bx, 1);
            pg8::EpiResidual E{C.out, modl + (f ? 8 : 2) * 1024, 0.5f};
            pg8::gemm_phase(C.lds, g, S, E);
        } break;
        case 5: {
            pg8::Gemm g{WSP(const bf16_t, WS_H), WSP(const bf16_t, W_IN), DM, DM, DM, 0, 0};
            pg8::TileOrder S; S.init(M, NIN, C.G, C.bx, 1);
            pg8::EpiInGate E{WSP(bf16_t, WS_PROJ), WSP(bf16_t, WS_GATES), C.in[I_BGATE] + (size_t)l * GATE_W};
            pg8::gemm_phase(C.lds, g, S, E);
        } break;
        case 6: qknorm_phase(C, l); conv_phase(C, l); break;
        case 7: dilated_phase(C); break;
        case 8: combine_phase(C); diff_phase(C, l); break;
        case 9: {
            pg8::Gemm g{WSP(const bf16_t, WS_Y), WSP(const bf16_t, W_BR), Y_W, 512, 512, 512, (long)DM * 512};
            pg8::TileOrder S; S.init(M, DM, C.G, C.bx, 3);
            pg8::EpiBranch E{WSP(const bf16_t, WS_GATES), WSP(float, WS_PROJ), WSP(bf16_t, WS_H)};
            pg8::gemm_phase(C.lds, g, S, E);
        } break;
        case 10: {
            pg8::Gemm g{WSP(const bf16_t, WS_H), WSP(const bf16_t, W_OUT), DM, DM, DM, 0, 0};
            pg8::TileOrder S; S.init(M, DM, C.G, C.bx, 1);
            pg8::EpiResidual E{C.out, modl + 5 * 1024, 1.0f};
            pg8::gemm_phase(C.lds, g, S, E);
        } break;
        default: break;
        }
        grid.sync();
    }
}

extern "C" void kernel_launch(void* const* d_in, const int* in_sizes, int n_in, void* d_out, int out_size, void* d_ws, size_t ws_size, hipStream_t stream) {
    static int grid = 0;
    if (grid == 0) {
        int dev = 0, cus = 0, per_cu = 0;
        if (n_in != 20 || out_size != M * DM || ws_size < WS_END) { fprintf(stderr, "kernel_launch: unexpected problem shape (n_in %d out %d ws %zu)\n", n_in, out_size, ws_size); grid = -1; return; }
        hipGetDevice(&dev);
        hipDeviceGetAttribute(&cus, hipDeviceAttributeMultiprocessorCount, dev);
        hipFuncSetAttribute((const void*)fwd_megakernel, hipFuncAttributeMaxDynamicSharedMemorySize, LDS_BYTES);
        hipOccupancyMaxActiveBlocksPerMultiprocessor(&per_cu, (const void*)fwd_megakernel, NTHREADS, LDS_BYTES);
        (void)hipGetLastError();
        if (per_cu < 1) { fprintf(stderr, "kernel_launch: occupancy query says %d blocks per CU\n", per_cu); per_cu = 1; }
        grid = cus;
    }
    if (grid < 0) return;
    Params p{};
    for (int i = 0; i < 20; ++i) p.in[i] = (const float*)d_in[i];
    p.out = (float*)d_out; p.ws = (unsigned char*)d_ws; p.dbg = 0; p.pad = 0;
    void* args[] = {&p};
    hipError_t e = hipLaunchCooperativeKernel((const void*)fwd_megakernel, dim3(grid), dim3(NTHREADS), args, LDS_BYTES, stream);
    if (e != hipSuccess) fprintf(stderr, "cooperative launch failed: %s (grid %d)\n", hipGetErrorString(e), grid);
}
```

```cpp
#include <hip/hip_runtime.h>
#include <hip/hip_cooperative_groups.h>
#include <cstdint>
#include <cstdio>
namespace cg = cooperative_groups;

#define LAS __attribute__((address_space(3)))
typedef unsigned short bf16_t;
typedef short bf16x8 __attribute__((ext_vector_type(8)));
typedef short s16x4 __attribute__((ext_vector_type(4)));
typedef float f32x2 __attribute__((ext_vector_type(2)));
typedef float f32x4 __attribute__((ext_vector_type(4)));
typedef float f32x16 __attribute__((ext_vector_type(16)));
typedef unsigned u32x2 __attribute__((ext_vector_type(2)));
typedef unsigned u32x4 __attribute__((ext_vector_type(4)));
typedef __bf16 bf16x2_t __attribute__((ext_vector_type(2)));

constexpr int BATCH = 4, SEQ = 4096, DM = 1024, M = BATCH * SEQ, DEPTH = 2;
constexpr int DFF = 2816, NUP = 2 * DFF;
constexpr int PROJ_W = 3584;
constexpr int GATE_W = 3072, Y_W = 1536, NIN = 7168;
constexpr int C_QA = 0, C_KA = 512, C_VA = 1024, C_QB = 1536, C_KB = 2048, C_VB = 2560, C_U = 3072;
constexpr float LOG2E = 1.4426950408889634f;
constexpr float QSCALE = 0.125f * LOG2E;
constexpr float NEGBIG = -1e30f;
constexpr float EPS = 1e-6f;

constexpr size_t MiB = 1u << 20;
constexpr size_t WS_CTL = 0;
constexpr size_t WS_MOD = 1 * MiB;
constexpr size_t WS_TBLA = WS_MOD + 512 * 1024;
constexpr size_t WS_TBLB = WS_TBLA + 32 * 1024;
constexpr size_t WS_LAM = WS_TBLB + 128 * 1024;
constexpr size_t WS_W = 2 * MiB;
constexpr size_t W_UP0 = WS_W, W_DN0 = W_UP0 + (size_t)NUP * DM * 2, W_UP1 = W_DN0 + (size_t)DM * DFF * 2, W_DN1 = W_UP1 + (size_t)NUP * DM * 2;
constexpr size_t W_IN = W_DN1 + (size_t)DM * DFF * 2, W_BR = W_IN + (size_t)NIN * DM * 2, W_OUT = W_BR + (size_t)3 * DM * 512 * 2;
constexpr size_t WS_H = 54 * MiB;
constexpr size_t WS_PROJ = 86 * MiB;
constexpr size_t WS_GATES = 198 * MiB;
constexpr size_t WS_Y = 294 * MiB;
constexpr size_t WS_LSE = 342 * MiB;
constexpr size_t WS_END = 344 * MiB;
static_assert(W_OUT + (size_t)DM * DM * 2 <= WS_H, "weights fit");

constexpr int LDS_BYTES = 147456;
constexpr int NTHREADS = 512;

struct Params { const float* in[20]; float* out; unsigned char* ws; int dbg; int pad; };
enum { I_X = 0, I_C, I_RELB, I_WADA, I_BADA, I_NORMG, I_WFFIN, I_WFFOUT, I_WIN, I_QKG, I_LAMV, I_SUBLN, I_CONVW, I_CONVB, I_CLNG, I_CLNB, I_WBR, I_WGATE, I_BGATE, I_WOUT };

__device__ __forceinline__ unsigned pk2(float lo, float hi) { f32x2 v = {lo, hi}; bf16x2_t b = __builtin_convertvector(v, bf16x2_t); return __builtin_bit_cast(unsigned, b); }
__device__ __forceinline__ float bf_lo(unsigned w) { return __uint_as_float(w << 16); }
__device__ __forceinline__ float bf_hi(unsigned w) { return __uint_as_float(w & 0xffff0000u); }
__device__ __forceinline__ float shx(float v, int m, int lane) { return __int_as_float(__builtin_amdgcn_ds_bpermute((lane ^ m) << 2, __float_as_int(v))); }
__device__ __forceinline__ float wave_sum(float v, int lane) {
#pragma unroll
    for (int o = 1; o < 64; o <<= 1) v += shx(v, o, lane);
    return v;
}
__device__ __forceinline__ float fast_exp2(float x) { return __builtin_amdgcn_exp2f(x); }
__device__ __forceinline__ float sigmoidf_(float x) { return __builtin_amdgcn_rcpf(1.0f + fast_exp2(-x * LOG2E)); }
__device__ __forceinline__ float siluf_(float x) { return x * sigmoidf_(x); }
__device__ __forceinline__ int crow(int r, int hi) { return (r & 3) + 8 * (r >> 2) + 4 * hi; }
__device__ __forceinline__ int t5_bucket(int d) {
    if (d < 16) return d;
    const int thr[15] = {22, 30, 40, 54, 73, 99, 134, 182, 246, 332, 450, 609, 825, 1117, 1513};
    int b = 16;
#pragma unroll
    for (int i = 0; i < 15; ++i) b += (d >= thr[i]) ? 1 : 0;
    return b;
}

namespace pg8 {
constexpr int BM = 256, BK = 64, HALF = 128, HTB = HALF * BK * 2, NXCD = 8, WGM = 8;
__host__ __device__ __forceinline__ int lds_byte(int r, int c) { const int st = (r >> 4) * 2 + (c >> 5), rr = r & 15, cc = c & 31, ob = rr * 64 + cc * 2; return st * 1024 + (ob ^ (((ob >> 9) & 1) << 5)); }
__host__ __device__ __forceinline__ void stage_rc(int b, int& R, int& C) { const int st = b / 1024, sb = b % 1024, swz = sb ^ (((sb >> 9) & 1) << 5); R = (st >> 1) * 16 + swz / 64; C = (st & 1) * 32 + (swz % 64) / 2; }
__host__ __device__ __forceinline__ int perm32(int rho) { const int n = rho >> 4, i = rho & 15; return 8 * (i >> 2) + 4 * n + (i & 3); }

struct Unit { int pm, pn, z; };
struct Gemm { const bf16_t* A; const bf16_t* Bt; int lda, ldb, K; long zA, zB; };

struct TileOrder {
    int nM, nN, nwg, G, c, zn;
    __device__ void init(int Mrows, int N, int G_, int c_, int zn_) { nM = Mrows / BM; nN = N / BM; nwg = nM * nN; G = G_; c = c_; zn = zn_; }
    __device__ bool next(int i, Unit& u) const {
        const int ti = i / zn; u.z = i - ti * zn;
        const long L = (long)ti * G + c; if (L >= nwg) return false;
        int wgid = (int)L; { const int q = nwg / NXCD, r = nwg % NXCD, xcd = wgid % NXCD, off = wgid / NXCD; wgid = (xcd < r ? xcd * (q + 1) : r * (q + 1) + (xcd - r) * q) + off; }
        const int nig = WGM * nN, gid = wgid / nig, fm = gid * WGM, gsz = (nM - fm) < WGM ? (nM - fm) : WGM;
        u.pm = fm + ((wgid % nig) % gsz); u.pn = (wgid % nig) / gsz; return true;
    }
};

template <class Epi>
__device__ __forceinline__ void gemm_phase(LAS unsigned char* lds, const Gemm g, const TileOrder& S, const Epi& E) {
    int tid = threadIdx.x; asm volatile("" : "+v"(tid));
    const int wid = __builtin_amdgcn_readfirstlane(tid >> 6), lane = tid & 63, wr = wid >> 2, wc = wid & 3, fr = lane & 15, fq = lane >> 4;
    const int K = g.K, nt = K / BK;
    unsigned voffA[2], voffB[2];
#pragma unroll
    for (int i = 0; i < 2; ++i) { int R, C; stage_rc(tid * 16 + i * 8192, R, C); const int Rb = Epi::PERM ? ((R & ~31) + perm32(R & 31)) : R;
        voffA[i] = (unsigned)(R * g.lda + C) * 2u; voffB[i] = (unsigned)(Rb * g.ldb + C) * 2u; }
    const size_t kstep = (size_t)(BK * 2);
    const size_t hstepA = (size_t)HALF * g.lda * 2, hstepB = (size_t)HALF * g.ldb * 2;
    const size_t tstepA = 2 * hstepA, tstepB = 2 * hstepB;
    const unsigned ldsw = (unsigned)wid * 1024u;
    const int aoff = lds_byte(wr * 64 + fr, fq * 8), boff = lds_byte(wc * 32 + fr, fq * 8);
#define PG8_SA(b, h) (((b) * 2 + (h)) * HTB)
#define PG8_SB(b, h) ((4 + (b) * 2 + (h)) * HTB)
#define PG8_STAGE(bufoff, gbase, voff) do { _Pragma("unroll") for (int _i = 0; _i < 2; ++_i) \
        __builtin_amdgcn_global_load_lds((const unsigned*)((const char*)(gbase) + (voff)[_i]), (LAS unsigned*)(lds + (bufoff) + ldsw + _i * 8192), 16, 0, 0); } while (0)
#define PG8_LDA(dst, b, h) do { _Pragma("unroll") for (int m = 0; m < 4; ++m) _Pragma("unroll") for (int k = 0; k < 2; ++k) dst[m][k] = *(const LAS bf16x8*)(lds + PG8_SA(b, h) + aoff + m * 2048 + k * 1024); } while (0)
#define PG8_LDB(dst, b, h) do { _Pragma("unroll") for (int n = 0; n < 2; ++n) _Pragma("unroll") for (int k = 0; k < 2; ++k) dst[n][k] = *(const LAS bf16x8*)(lds + PG8_SB(b, h) + boff + n * 2048 + k * 1024); } while (0)
#define PG8_MMA(ai, bj, At, Bt) do { __builtin_amdgcn_s_setprio(1); _Pragma("unroll") for (int m = 0; m < 4; ++m) _Pragma("unroll") for (int n = 0; n < 2; ++n) _Pragma("unroll") for (int k = 0; k < 2; ++k) \
        acc[ai][bj][m][n] = __builtin_amdgcn_mfma_f32_16x16x32_bf16(Bt[n][k], At[m][k], acc[ai][bj][m][n], 0, 0, 0); __builtin_amdgcn_s_setprio(0); } while (0)
#define PG8_WAIT_V(n) asm volatile("s_waitcnt vmcnt(" #n ")" ::: "memory")
#define PG8_WAIT_L(n) asm volatile("s_waitcnt lgkmcnt(" #n ")" ::: "memory")
#define PG8_BAR __builtin_amdgcn_s_barrier()
#define PG8_SCHED __builtin_amdgcn_sched_barrier(0)
    Unit cur, nxt; int ui = 0;
    if (!S.next(0, cur)) return;
    f32x4 acc[2][2][4][2];
#pragma unroll
    for (int a = 0; a < 2; ++a)
#pragma unroll
        for (int b = 0; b < 2; ++b)
#pragma unroll
            for (int m = 0; m < 4; ++m)
#pragma unroll
                for (int n = 0; n < 2; ++n) acc[a][b][m][n] = (f32x4){0.f, 0.f, 0.f, 0.f};
    bf16x8 At[4][2], B0[2][2], B1[2][2];
    const char* cA = (const char*)g.A + (size_t)cur.pm * tstepA + (size_t)cur.z * g.zA * 2; const char* cB = (const char*)g.Bt + (size_t)cur.pn * tstepB + (size_t)cur.z * g.zB * 2;
    PG8_STAGE(PG8_SB(0, 0), cB, voffB); PG8_STAGE(PG8_SB(0, 1), cB + hstepB, voffB); PG8_STAGE(PG8_SA(0, 0), cA, voffA); PG8_STAGE(PG8_SA(0, 1), cA + hstepA, voffA);
    if (wr == 1) PG8_BAR;
    PG8_WAIT_V(2); PG8_BAR;
    PG8_STAGE(PG8_SB(1, 0), cB + kstep, voffB); PG8_STAGE(PG8_SA(1, 0), cA + kstep, voffA); PG8_STAGE(PG8_SB(1, 1), cB + hstepB + kstep, voffB);
    PG8_WAIT_V(6); PG8_BAR;
    for (;;) {
        const bool has_next = S.next(ui + 1, nxt);
        const char* nA = has_next ? (const char*)g.A + (size_t)nxt.pm * tstepA + (size_t)nxt.z * g.zA * 2 : cA; const char* nB = has_next ? (const char*)g.Bt + (size_t)nxt.pn * tstepB + (size_t)nxt.z * g.zB * 2 : cB;
        for (int t = 0; t < nt; t += 2) {
            const bool last = (t == nt - 2);
            const char* a1 = cA + (size_t)(t + 1) * kstep;
            const char* a2 = last ? nA : cA + (size_t)(t + 2) * kstep; const char* b2 = last ? nB : cB + (size_t)(t + 2) * kstep;
            const char* a3 = a2 + kstep; const char* b3 = b2 + kstep;
            PG8_LDB(B0, 0, 0); PG8_LDB(B1, 0, 1); PG8_SCHED; PG8_LDA(At, 0, 0); PG8_STAGE(PG8_SA(1, 1), a1 + hstepA, voffA);
            PG8_WAIT_V(8); PG8_WAIT_L(0); PG8_BAR; PG8_MMA(0, 0, At, B0); PG8_MMA(0, 1, At, B1); PG8_BAR; PG8_SCHED;
            PG8_LDA(At, 0, 1); PG8_STAGE(PG8_SB(0, 0), b2, voffB); PG8_STAGE(PG8_SB(0, 1), b2 + hstepB, voffB); PG8_STAGE(PG8_SA(0, 0), a2, voffA);
            PG8_WAIT_V(8); PG8_WAIT_L(0); PG8_BAR; PG8_MMA(1, 0, At, B0); PG8_MMA(1, 1, At, B1); PG8_BAR; PG8_SCHED;
            PG8_LDB(B0, 1, 0); PG8_LDB(B1, 1, 1); PG8_SCHED; PG8_LDA(At, 1, 0); PG8_STAGE(PG8_SA(0, 1), a2 + hstepA, voffA);
            PG8_WAIT_V(8); PG8_WAIT_L(0); PG8_BAR; PG8_MMA(0, 0, At, B0); PG8_MMA(0, 1, At, B1); PG8_BAR; PG8_SCHED;
            PG8_LDA(At, 1, 1); PG8_STAGE(PG8_SB(1, 0), b3, voffB); PG8_STAGE(PG8_SB(1, 1), b3 + hstepB, voffB); PG8_STAGE(PG8_SA(1, 0), a3, voffA);
            PG8_WAIT_V(8); PG8_WAIT_L(0); PG8_BAR; PG8_MMA(1, 0, At, B0); PG8_MMA(1, 1, At, B1); PG8_BAR; PG8_SCHED;
        }
        if (wr == 0) PG8_BAR;
        E(acc, cur, wr, wc, fr, fq);
        if (!has_next) break;
#pragma unroll
        for (int a = 0; a < 2; ++a)
#pragma unroll
            for (int b = 0; b < 2; ++b)
#pragma unroll
                for (int m = 0; m < 4; ++m)
#pragma unroll
                    for (int n = 0; n < 2; ++n) acc[a][b][m][n] = (f32x4){0.f, 0.f, 0.f, 0.f};
        cur = nxt; cA = nA; cB = nB; ++ui;
        if (wr == 1) PG8_BAR;
    }
    PG8_WAIT_V(0);
    PG8_BAR;
#undef PG8_SA
#undef PG8_SB
#undef PG8_STAGE
#undef PG8_LDA
#undef PG8_LDB
#undef PG8_MMA
#undef PG8_WAIT_V
#undef PG8_WAIT_L
#undef PG8_BAR
#undef PG8_SCHED
}

__device__ __forceinline__ u32x4 pack8(const f32x4 a, const f32x4 b) { u32x4 w; w.x = pk2(a[0], a[1]); w.y = pk2(a[2], a[3]); w.z = pk2(b[0], b[1]); w.w = pk2(b[2], b[3]); return w; }

struct EpiSwiGLU {
    static constexpr bool PERM = true;
    bf16_t* O;
    __device__ __forceinline__ void operator()(const f32x4 (&acc)[2][2][4][2], const Unit& u, int wr, int wc, int fr, int fq) const {
        const int row0 = u.pm * BM + wr * 64 + fr, col0 = u.pn * HALF + wc * 32 + 8 * fq;
#pragma unroll
        for (int ai = 0; ai < 2; ++ai)
#pragma unroll
            for (int m = 0; m < 4; ++m) {
                f32x4 h0, h1;
#pragma unroll
                for (int i = 0; i < 4; ++i) { h0[i] = siluf_(acc[ai][0][m][0][i]) * acc[ai][1][m][0][i]; h1[i] = siluf_(acc[ai][0][m][1][i]) * acc[ai][1][m][1][i]; }
                *(u32x4*)(O + (size_t)(row0 + ai * HALF + m * 16) * DFF + col0) = pack8(h0, h1);
            }
    }
};
struct EpiResidual {
    static constexpr bool PERM = false;
    float* out; const float* gvec; float coef;
    __device__ __forceinline__ void operator()(const f32x4 (&acc)[2][2][4][2], const Unit& u, int wr, int wc, int fr, int fq) const {
        const int row0 = u.pm * BM + wr * 64 + fr, col0 = u.pn * BM + wc * 32 + 4 * fq; const int b = u.pm >> 4;
        f32x4 gv[2][2];
#pragma unroll
        for (int bj = 0; bj < 2; ++bj)
#pragma unroll
            for (int n = 0; n < 2; ++n) gv[bj][n] = *(const f32x4*)(gvec + (size_t)b * 9216 + col0 + bj * HALF + n * 16) * coef;
#pragma unroll
        for (int ai = 0; ai < 2; ++ai)
#pragma unroll
            for (int m = 0; m < 4; ++m) { float* rowp = out + (size_t)(row0 + ai * HALF + m * 16) * DM + col0;
#pragma unroll
                for (int bj = 0; bj < 2; ++bj)
#pragma unroll
                    for (int n = 0; n < 2; ++n) { float* p = rowp + bj * HALF + n * 16; *(f32x4*)p = *(const f32x4*)p + gv[bj][n] * acc[ai][bj][m][n]; } }
    }
};
struct EpiInGate {
    static constexpr bool PERM = true;
    bf16_t* proj; bf16_t* gates; const float* bgate;
    __device__ __forceinline__ void operator()(const f32x4 (&acc)[2][2][4][2], const Unit& u, int wr, int wc, int fr, int fq) const {
        const int row0 = u.pm * BM + wr * 64 + fr; const int cw = wc * 32 + 8 * fq;
        if (u.pn < 12) {
#pragma unroll
            for (int ai = 0; ai < 2; ++ai)
#pragma unroll
                for (int m = 0; m < 4; ++m) { bf16_t* rp = proj + (size_t)(row0 + ai * HALF + m * 16) * PROJ_W + u.pn * BM + cw;
#pragma unroll
                    for (int bj = 0; bj < 2; ++bj) *(u32x4*)(rp + bj * HALF) = pack8(acc[ai][bj][m][0], acc[ai][bj][m][1]); }
        } else if (u.pn < 16) {
#pragma unroll
            for (int ai = 0; ai < 2; ++ai)
#pragma unroll
                for (int m = 0; m < 4; ++m) { f32x4 h0, h1;
#pragma unroll
                    for (int i = 0; i < 4; ++i) { h0[i] = acc[ai][0][m][0][i] * sigmoidf_(acc[ai][1][m][0][i]); h1[i] = acc[ai][0][m][1][i] * sigmoidf_(acc[ai][1][m][1][i]); }
                    *(u32x4*)(proj + (size_t)(row0 + ai * HALF + m * 16) * PROJ_W + C_U + (u.pn - 12) * HALF + cw) = pack8(h0, h1); }
        } else {
            const int cb = (u.pn - 16) * BM + cw;
            f32x4 bv[2][2];
#pragma unroll
            for (int bj = 0; bj < 2; ++bj) { bv[bj][0] = *(const f32x4*)(bgate + cb + bj * HALF); bv[bj][1] = *(const f32x4*)(bgate + cb + bj * HALF + 4); }
#pragma unroll
            for (int ai = 0; ai < 2; ++ai)
#pragma unroll
                for (int m = 0; m < 4; ++m) { bf16_t* rp = gates + (size_t)(row0 + ai * HALF + m * 16) * GATE_W + cb;
#pragma unroll
                    for (int bj = 0; bj < 2; ++bj) { f32x4 h0, h1;
#pragma unroll
                        for (int i = 0; i < 4; ++i) { h0[i] = sigmoidf_(acc[ai][bj][m][0][i] + bv[bj][0][i]); h1[i] = sigmoidf_(acc[ai][bj][m][1][i] + bv[bj][1][i]); }
                        *(u32x4*)(rp + bj * HALF) = pack8(h0, h1); } }
        }
    }
};
struct EpiBranch {
    static constexpr bool PERM = true;
    const bf16_t* gates; float* tmp; bf16_t* merged;
    __device__ __forceinline__ void operator()(const f32x4 (&acc)[2][2][4][2], const Unit& u, int wr, int wc, int fr, int fq) const {
        const int row0 = u.pm * BM + wr * 64 + fr; const int cb = u.pn * BM + wc * 32 + 8 * fq; const int z = u.z;
#pragma unroll
        for (int ai = 0; ai < 2; ++ai)
#pragma unroll
            for (int m = 0; m < 4; ++m) { const size_t row = (size_t)(row0 + ai * HALF + m * 16);
#pragma unroll
                for (int bj = 0; bj < 2; ++bj) {
                    const u32x4 gw = *(const u32x4*)(gates + row * GATE_W + z * 1024 + cb + bj * HALF);
                    f32x4 t0, t1;
                    t0[0] = bf_lo(gw.x) * acc[ai][bj][m][0][0]; t0[1] = bf_hi(gw.x) * acc[ai][bj][m][0][1]; t0[2] = bf_lo(gw.y) * acc[ai][bj][m][0][2]; t0[3] = bf_hi(gw.y) * acc[ai][bj][m][0][3];
                    t1[0] = bf_lo(gw.z) * acc[ai][bj][m][1][0]; t1[1] = bf_hi(gw.z) * acc[ai][bj][m][1][1]; t1[2] = bf_lo(gw.w) * acc[ai][bj][m][1][2]; t1[3] = bf_hi(gw.w) * acc[ai][bj][m][1][3];
                    float* tp = tmp + row * DM + cb + bj * HALF;
                    if (z > 0) { t0 += *(const f32x4*)tp; t1 += *(const f32x4*)(tp + 4); }
                    if (z < 2) { *(f32x4*)tp = t0; *(f32x4*)(tp + 4) = t1; }
                    else *(u32x4*)(merged + row * DM + cb + bj * HALF) = pack8(t0, t1);
                } }
    }
};
}

struct Ctx {
    LAS unsigned char* lds;
    int tid, lane, wave, G, vcu, bx;
    const float* const* in;
    float* out; unsigned char* ws;
};
#define WSP(T, off) ((T*)(C.ws + (off)))
__device__ __forceinline__ Ctx rectx(const Ctx& C0) { Ctx C = C0; int t = threadIdx.x; asm volatile("" : "+v"(t)); C.tid = t; C.lane = t & 63; C.wave = __builtin_amdgcn_readfirstlane(t >> 6);
    int z = 0; asm volatile("" : "+s"(z)); C.G += z; C.bx += z; C.vcu += z; C.ws += z; C.out += z; C.in += z; C.lds += z; return C; }

__device__ __forceinline__ void transpose_item(const float* W, int ldw, int srccol0, int k0, bf16_t* WT, int K, int dstrow0, LAS float* scr, int lane) {
#pragma unroll 8
    for (int i = 0; i < 32; ++i) { const int kk = 2 * i + (lane >> 5); scr[kk * 33 + (lane & 31)] = W[(size_t)(k0 + kk) * ldw + srccol0 + (lane & 31)]; }
    asm volatile("s_waitcnt lgkmcnt(0)" ::: "memory");
    const int c = lane & 7;
#pragma unroll
    for (int j = 0; j < 4; ++j) { const int n = (lane >> 3) + 8 * j; const LAS float* s = scr + (8 * c) * 33 + n;
        u32x4 o; o.x = pk2(s[0 * 33], s[1 * 33]); o.y = pk2(s[2 * 33], s[3 * 33]); o.z = pk2(s[4 * 33], s[5 * 33]); o.w = pk2(s[6 * 33], s[7 * 33]);
        *(u32x4*)(WT + (size_t)(dstrow0 + n) * K + k0 + 8 * c) = o; }
    asm volatile("s_waitcnt lgkmcnt(0)" ::: "memory");
}
__device__ __forceinline__ int up_srccol(int n0) { const int tile = n0 >> 8, half = (n0 >> 7) & 1, j = n0 & 127; return half * DFF + tile * 128 + j; }
__device__ __forceinline__ int win_srccol(int n0) { if (n0 < 3072) return n0; const int t = (n0 - 3072) >> 8, half = ((n0 - 3072) >> 7) & 1, j = n0 & 127; return 3072 + half * 512 + t * 128 + j; }

__device__ __forceinline__ void convert_weights(const Ctx& C0, int l) {
    const Ctx C = rectx(C0);
    LAS float* scr = (LAS float*)(C.lds + C.wave * 16384);
    const int gw = C.vcu * 8 + C.wave, NGW = C.G * 8;
    constexpr int I_UP = (DM / 64) * (NUP / 32), I_DN = (DFF / 64) * (DM / 32), I_INA = (DM / 64) * (4096 / 32), I_INB = (DM / 64) * (3072 / 32), I_BRN = (512 / 64) * (DM / 32), I_OUTN = (DM / 64) * (DM / 32);
    constexpr int NITEMS = 2 * I_UP + 2 * I_DN + I_INA + I_INB + 3 * I_BRN + I_OUTN;
    const float* wffin = C.in[I_WFFIN] + (size_t)l * 2 * DM * NUP;
    const float* wffout = C.in[I_WFFOUT] + (size_t)l * 2 * DFF * DM;
    const float* win = C.in[I_WIN] + (size_t)l * DM * 4096;
    const float* wgate = C.in[I_WGATE] + (size_t)l * DM * 3072;
    const float* wbr = C.in[I_WBR] + (size_t)l * 3 * 512 * DM;
    const float* wout = C.in[I_WOUT] + (size_t)l * DM * DM;
    for (int it = gw; it < NITEMS; it += NGW) {
        int r = it;
        if (r < 2 * I_UP) { const int f = r / I_UP; r -= f * I_UP; const int nblk = NUP / 32, kb = r / nblk, nb = r % nblk;
            transpose_item(wffin + (size_t)f * DM * NUP, NUP, up_srccol(nb * 32), kb * 64, WSP(bf16_t, f ? W_UP1 : W_UP0), DM, nb * 32, scr, C.lane); continue; }
        r -= 2 * I_UP;
        if (r < 2 * I_DN) { const int f = r / I_DN; r -= f * I_DN; const int nblk = DM / 32, kb = r / nblk, nb = r % nblk;
            transpose_item(wffout + (size_t)f * DFF * DM, DM, nb * 32, kb * 64, WSP(bf16_t, f ? W_DN1 : W_DN0), DFF, nb * 32, scr, C.lane); continue; }
        r -= 2 * I_DN;
        if (r < I_INA) { const int nblk = 4096 / 32, kb = r / nblk, nb = r % nblk;
            transpose_item(win, 4096, win_srccol(nb * 32), kb * 64, WSP(bf16_t, W_IN), DM, nb * 32, scr, C.lane); continue; }
        r -= I_INA;
        if (r < I_INB) { const int nblk = 3072 / 32, kb = r / nblk, nb = r % nblk;
            transpose_item(wgate, 3072, nb * 32, kb * 64, WSP(bf16_t, W_IN), DM, 4096 + nb * 32, scr, C.lane); continue; }
        r -= I_INB;
        if (r < 3 * I_BRN) { const int gI = r / I_BRN; r -= gI * I_BRN; const int nblk = DM / 32, kb = r / nblk, nb = r % nblk;
            transpose_item(wbr + (size_t)gI * 512 * DM, DM, nb * 32, kb * 64, WSP(bf16_t, W_BR) + (size_t)gI * DM * 512, 512, nb * 32, scr, C.lane); continue; }
        r -= 3 * I_BRN;
        { const int nblk = DM / 32, kb = r / nblk, nb = r % nblk;
            transpose_item(wout, DM, nb * 32, kb * 64, WSP(bf16_t, W_OUT), DM, nb * 32, scr, C.lane); }
    }
}

__device__ __forceinline__ void prologue_misc(const Ctx& C0) {
    const Ctx C = rectx(C0);
    const int gtid = C.bx * NTHREADS + C.tid, NT = C.G * NTHREADS;
    {
        const f32x4* s = (const f32x4*)C.in[I_X]; f32x4* d = (f32x4*)C.out;
        for (int i = gtid; i < M * DM / 4; i += NT) d[i] = s[i];
    }
    {
        const float* relb = C.in[I_RELB];
        float* ta = WSP(float, WS_TBLA); float* tb = WSP(float, WS_TBLB);
        for (int i = gtid; i < 3 * 8 * 192; i += NT) { const int p = i / (8 * 192), h = (i / 192) % 8, idx = i % 192, rel = idx - 32; const int dil = (p == 0) ? 1 : (p == 1 ? 4 : 16);
            ta[i] = (rel >= 0 && rel <= 128) ? relb[t5_bucket(rel * dil) * 12 + h] * LOG2E : NEGBIG; }
        for (int i = gtid; i < 4 * 4224; i += NT) { const int h = i / 4224, dist = (i % 4224) - 128;
            tb[i] = (dist >= 0) ? relb[t5_bucket(dist) * 12 + 8 + h] * LOG2E : NEGBIG; }
        if (gtid < DEPTH) { const float* lv = C.in[I_LAMV] + gtid * 256; float a = 0.f, b = 0.f;
            for (int i = 0; i < 64; ++i) { a += lv[i] * lv[64 + i]; b += lv[128 + i] * lv[192 + i]; }
            const float lam_init = 0.8f - 0.6f * expf(-0.3f * (float)gtid);
            WSP(float, WS_LAM)[gtid] = expf(a) - expf(b) + lam_init; }
    }
    {
        LAS float* sc = (LAS float*)C.lds;
        LAS float* red = (LAS float*)(C.lds + 16384);
        const float* cin = C.in[I_C];
        for (int i = C.tid; i < 4096; i += NTHREADS) sc[i] = siluf_(cin[i]);
        __syncthreads();
        for (int it = C.bx; it < 2 * 144; it += C.G) {
            const int l = it / 144, cb = it % 144; const int e = cb * 64 + C.lane;
            const float* w = C.in[I_WADA] + (size_t)l * DM * 9216 + e;
            float a0 = 0.f, a1 = 0.f, a2 = 0.f, a3 = 0.f; const int d0 = C.wave * 128;
#pragma unroll 8
            for (int d = 0; d < 128; ++d) { const float wv = w[(size_t)(d0 + d) * 9216]; a0 += sc[d0 + d] * wv; a1 += sc[1024 + d0 + d] * wv; a2 += sc[2048 + d0 + d] * wv; a3 += sc[3072 + d0 + d] * wv; }
            red[(C.wave * 4 + 0) * 64 + C.lane] = a0; red[(C.wave * 4 + 1) * 64 + C.lane] = a1; red[(C.wave * 4 + 2) * 64 + C.lane] = a2; red[(C.wave * 4 + 3) * 64 + C.lane] = a3;
            __syncthreads();
            if (C.tid < 256) { const int b = C.tid >> 6, ln = C.tid & 63; float s = 0.f;
#pragma unroll
                for (int w8 = 0; w8 < 8; ++w8) s += red[(w8 * 4 + b) * 64 + ln];
                const int ee = cb * 64 + ln;
                WSP(float, WS_MOD)[((size_t)l * 4 + b) * 9216 + ee] = s + C.in[I_BADA][l * 9216 + ee]; }
            __syncthreads();
        }
    }
}

__device__ __forceinline__ void norm_phase(const Ctx& C0, int l, int which) {
    const Ctx C = rectx(C0);
    const int gw = C.vcu * 8 + C.wave, NGW = C.G * 8;
    const float* g = C.in[I_NORMG] + ((size_t)l * 3 + which) * DM;
    const float* mod = WSP(float, WS_MOD) + (size_t)l * 4 * 9216;
    bf16_t* H = WSP(bf16_t, WS_H);
    for (int row = gw; row < M; row += NGW) {
        const int b = row >> 12;
        const f32x4* xr = (const f32x4*)(C.out + (size_t)row * DM) + C.lane;
        const f32x4* sh = (const f32x4*)(mod + (size_t)b * 9216 + (3 * which) * 1024) + C.lane;
        const f32x4* scl = (const f32x4*)(mod + (size_t)b * 9216 + (3 * which + 1) * 1024) + C.lane;
        const f32x4* gg = (const f32x4*)g + C.lane;
        f32x4 v[4]; float s = 0.f;
#pragma unroll
        for (int j = 0; j < 4; ++j) { v[j] = xr[64 * j]; s += (v[j].x * v[j].x + v[j].y * v[j].y) + (v[j].z * v[j].z + v[j].w * v[j].w); }
        const float rstd = 1.0f / sqrtf(wave_sum(s, C.lane) * (1.0f / DM) + EPS);
        u32x2* o8 = (u32x2*)(H + (size_t)row * DM) + C.lane;
#pragma unroll
        for (int j = 0; j < 4; ++j) { const f32x4 gv = gg[64 * j], sv = scl[64 * j], hv = sh[64 * j];
            f32x4 y = (v[j] * rstd) * gv; y = y * (sv + 1.0f) + hv;
            u32x2 w; w.x = pk2(y.x, y.y); w.y = pk2(y.z, y.w); o8[64 * j] = w; }
    }
}

__device__ __forceinline__ void qknorm_phase(const Ctx& C0, int l) {
    const Ctx C = rectx(C0);
    const int gw = C.vcu * 8 + C.wave, NGW = C.G * 8;
    const float* qkg = C.in[I_QKG] + (size_t)l * 6 * 64;
    bf16_t* proj = WSP(bf16_t, WS_PROJ);
    const int d0 = (C.lane & 7) * 8, grp = C.lane >> 3;
    for (int row = gw; row < M; row += NGW) {
#pragma unroll
        for (int sec = 0; sec < 4; ++sec) {
            const int cbase = (sec == 0) ? C_QA : (sec == 1) ? C_KA : (sec == 2) ? C_QB : C_KB;
            int gi; float sc;
            if (sec == 0) { gi = 0; sc = QSCALE; } else if (sec == 1) { gi = 1; sc = 1.f; } else if (sec == 2) { gi = 2 + (grp & 1); sc = QSCALE; } else { gi = 4 + (grp & 1); sc = 1.f; }
            u32x4* p = (u32x4*)(proj + (size_t)row * PROJ_W + cbase + C.lane * 8);
            const u32x4 w = *p;
            float x[8] = {bf_lo(w.x), bf_hi(w.x), bf_lo(w.y), bf_hi(w.y), bf_lo(w.z), bf_hi(w.z), bf_lo(w.w), bf_hi(w.w)};
            float s = 0.f;
#pragma unroll
            for (int i = 0; i < 8; ++i) s += x[i] * x[i];
            s += shx(s, 1, C.lane); s += shx(s, 2, C.lane); s += shx(s, 4, C.lane);
            const float r = sc / sqrtf(s * (1.0f / 64.0f) + EPS);
            const f32x4 g0 = *(const f32x4*)(qkg + gi * 64 + d0), g1 = *(const f32x4*)(qkg + gi * 64 + d0 + 4);
            u32x4 o; o.x = pk2(x[0] * r * g0.x, x[1] * r * g0.y); o.y = pk2(x[2] * r * g0.z, x[3] * r * g0.w); o.z = pk2(x[4] * r * g1.x, x[5] * r * g1.y); o.w = pk2(x[6] * r * g1.z, x[7] * r * g1.w);
            *p = o;
        }
    }
}

__device__ __forceinline__ void conv_phase(const Ctx& C0, int l) {
    const Ctx C = rectx(C0);
    const bf16_t* proj = WSP(const bf16_t, WS_PROJ); bf16_t* Y = WSP(bf16_t, WS_Y);
    LAS bf16_t* ut = (LAS bf16_t*)C.lds;
    LAS float* yt = (LAS float*)(C.lds + 65536);
    const int c = C.tid;
    float w[31];
#pragma unroll
    for (int j = 0; j < 31; ++j) w[j] = C.in[I_CONVW][((size_t)l * 31 + j) * 512 + c];
    const float cb = C.in[I_CONVB][l * 512 + c];
    const float* lng = C.in[I_CLNG] + l * 512; const float* lnb = C.in[I_CLNB] + l * 512;
    for (int un = C.vcu; un < M / 32; un += C.G) {
        const int row0 = un * 32, t0 = row0 & (SEQ - 1);
        for (int i = C.tid; i < 62 * 64; i += NTHREADS) { const int rr = i >> 6, ch = i & 63; const int t = t0 - 30 + rr;
            u32x4 v = (u32x4){0u, 0u, 0u, 0u};
            if (t >= 0) v = *(const u32x4*)(proj + (size_t)(row0 - 30 + rr) * PROJ_W + C_U + ch * 8);
            *(LAS u32x4*)(ut + rr * 512 + ch * 8) = v; }
        __syncthreads();
#pragma unroll 1
        for (int g8 = 0; g8 < 4; ++g8) {
            float uu[38];
#pragma unroll
            for (int i = 0; i < 38; ++i) uu[i] = __uint_as_float((unsigned)ut[(g8 * 8 + i) * 512 + c] << 16);
#pragma unroll
            for (int i = 0; i < 8; ++i) { float a = cb;
#pragma unroll
                for (int j = 0; j < 31; ++j) a += w[j] * uu[i + j];
                yt[(g8 * 8 + i) * 512 + c] = a; }
        }
        __syncthreads();
#pragma unroll
        for (int rr = 0; rr < 4; ++rr) { const int r = C.wave * 4 + rr; const LAS float* yr = yt + r * 512 + C.lane * 8;
            float x[8]; float s = 0.f;
#pragma unroll
            for (int i = 0; i < 8; ++i) { x[i] = yr[i]; s += x[i]; }
            const float mean = wave_sum(s, C.lane) * (1.0f / 512.0f); float q = 0.f;
#pragma unroll
            for (int i = 0; i < 8; ++i) { x[i] -= mean; q += x[i] * x[i]; }
            const float rstd = 1.0f / sqrtf(wave_sum(q, C.lane) * (1.0f / 512.0f) + EPS);
            float o[8];
#pragma unroll
            for (int i = 0; i < 8; ++i) { const float v = x[i] * rstd * lng[C.lane * 8 + i] + lnb[C.lane * 8 + i]; o[i] = siluf_(v); }
            u32x4 pw; pw.x = pk2(o[0], o[1]); pw.y = pk2(o[2], o[3]); pw.z = pk2(o[4], o[5]); pw.w = pk2(o[6], o[7]);
            *(u32x4*)(Y + (size_t)(row0 + r) * Y_W + 1024 + C.lane * 8) = pw; }
        __syncthreads();
    }
}

__device__ __forceinline__ s16x4 vtr(const LAS unsigned char* p) { return __builtin_bit_cast(s16x4, __builtin_amdgcn_ds_read_tr16_b64_v4i16((LAS s16x4*)p)); }
__device__ __forceinline__ bf16x8 vfrag(const LAS unsigned char* p) { const s16x4 lo = vtr(p), hi = vtr(p + 512); return (bf16x8){lo[0], lo[1], lo[2], lo[3], hi[0], hi[1], hi[2], hi[3]}; }
__device__ __forceinline__ bf16x8 pfrag(const f32x16& p, int s) {
    u32x4 w; w.x = pk2(p[8 * s + 0], p[8 * s + 1]); w.y = pk2(p[8 * s + 2], p[8 * s + 3]); w.z = pk2(p[8 * s + 4], p[8 * s + 5]); w.w = pk2(p[8 * s + 6], p[8 * s + 7]);
    return __builtin_bit_cast(bf16x8, w);
}

__device__ __forceinline__ void dilated_phase(const Ctx& C0) {
    const Ctx C = rectx(C0);
    const bf16_t* proj = WSP(const bf16_t, WS_PROJ);
    LAS unsigned char* Kl = C.lds;
    LAS unsigned char* Vl = C.lds + 49152;
    LAS float* tbl = (LAS float*)(C.lds + 98304);
    const int lane = C.lane, r32 = lane & 31, hi = lane >> 5, w = C.wave;
    const int vlane = ((lane >> 4) & 1) * 32 + (lane & 3) * 8 + (4 * hi + ((lane & 15) >> 2)) * 64;
    for (int uid = C.vcu; uid < 1536; uid += C.G) {
        const int p = uid >> 9, rem = uid & 511, bh = rem >> 4, ru = rem & 15;
        const int dil = (p == 0) ? 1 : (p == 1 ? 4 : 16), nu = 16 / dil, r = ru / nu, u = ru % nu;
        const int b = bh >> 3, h = bh & 7;
        const size_t tokbase = (size_t)b * SEQ;
        if (C.tid < 192) tbl[C.tid] = WSP(const float, WS_TBLA)[(p * 8 + h) * 192 + C.tid];
        u32x4 kreg[6], vreg[6];
#pragma unroll
        for (int i = 0; i < 6; ++i) { const int idx = C.tid + 512 * i;
            { const int chunk = idx / 384, key = idx - chunk * 384; const int sidx = 256 * u - 128 + key;
              kreg[i] = (u32x4){0u, 0u, 0u, 0u};
              if (sidx >= 0) kreg[i] = *(const u32x4*)(proj + (tokbase + (size_t)sidx * dil + r) * PROJ_W + C_KA + h * 64 + chunk * 8); }
            { const int dblk = idx / 1536, rm = idx - dblk * 1536, ks = rm >> 6, k16 = (rm & 63) >> 2, c4 = rm & 3; const int sidx = 256 * u - 128 + ks * 16 + k16;
              vreg[i] = (u32x4){0u, 0u, 0u, 0u};
              if (sidx >= 0) vreg[i] = *(const u32x4*)(proj + (tokbase + (size_t)sidx * dil + r) * PROJ_W + C_VA + h * 64 + dblk * 32 + c4 * 8); }
        }
#pragma unroll
        for (int i = 0; i < 6; ++i) { const int idx = C.tid + 512 * i; *(LAS u32x4*)(Kl + idx * 16) = kreg[i]; *(LAS u32x4*)(Vl + idx * 16) = vreg[i]; }
        const int iq = 32 * w + r32; const size_t tq = tokbase + (size_t)(256 * u + iq) * dil + r;
        bf16x8 qf[4];
#pragma unroll
        for (int d0 = 0; d0 < 4; ++d0) qf[d0] = *(const bf16x8*)(proj + tq * PROJ_W + C_QA + h * 64 + d0 * 16 + hi * 8);
        __syncthreads();
        f32x16 S[5]; float mx = NEGBIG;
#pragma unroll
        for (int s = 0; s < 5; ++s) {
            const bool skip = (u == 0) && (w + s < 4);
            if (!skip) {
                f32x16 a;
#pragma unroll
                for (int rg = 0; rg < 16; ++rg) a[rg] = tbl[(r32 + 5 - 4 * hi) + (128 - 32 * s) + 27 - ((rg & 3) + 8 * (rg >> 2))];
                const int jj0 = 32 * (w + s);
#pragma unroll
                for (int d0 = 0; d0 < 4; ++d0) { const bf16x8 kf = *(const LAS bf16x8*)(Kl + (2 * d0 + hi) * 6144 + (jj0 + r32) * 16);
                    a = __builtin_amdgcn_mfma_f32_32x32x16_bf16(kf, qf[d0], a, 0, 0, 0); }
                S[s] = a;
#pragma unroll
                for (int rg = 0; rg < 16; ++rg) mx = fmaxf(mx, a[rg]);
            } else {
#pragma unroll
                for (int rg = 0; rg < 16; ++rg) S[s][rg] = NEGBIG;
            }
        }
        mx = fmaxf(mx, shx(mx, 32, C.lane));
        float den = 0.f;
#pragma unroll
        for (int s = 0; s < 5; ++s)
#pragma unroll
            for (int rg = 0; rg < 16; ++rg) { const float e = fast_exp2(S[s][rg] - mx); S[s][rg] = e; den += e; }
        den += shx(den, 32, C.lane);
        f32x16 o[2]; o[0] = (f32x16){}; o[1] = (f32x16){};
#pragma unroll
        for (int s = 0; s < 5; ++s) {
            const bool skip = (u == 0) && (w + s < 4);
            if (!skip) {
#pragma unroll
                for (int s16 = 0; s16 < 2; ++s16) { const int ksg = 2 * (w + s) + s16; const bf16x8 pf = pfrag(S[s], s16);
#pragma unroll
                    for (int dblk = 0; dblk < 2; ++dblk) { const bf16x8 vf = vfrag(Vl + dblk * 24576 + ksg * 1024 + vlane);
                        o[dblk] = __builtin_amdgcn_mfma_f32_32x32x16_bf16(vf, pf, o[dblk], 0, 0, 0); } }
            }
        }
        const float rden = 1.0f / den;
        bf16_t* Op; int opitch;
        if (p == 0) { Op = WSP(bf16_t, WS_Y); opitch = Y_W; } else { Op = WSP(bf16_t, WS_H) + (size_t)(p - 1) * M * 512; opitch = 512; }
        bf16_t* orow = Op + tq * opitch + h * 64;
#pragma unroll
        for (int dblk = 0; dblk < 2; ++dblk)
#pragma unroll
            for (int rg = 0; rg < 4; ++rg) { u32x2 wv; wv.x = pk2(o[dblk][4 * rg] * rden, o[dblk][4 * rg + 1] * rden); wv.y = pk2(o[dblk][4 * rg + 2] * rden, o[dblk][4 * rg + 3] * rden);
                *(u32x2*)(orow + 32 * dblk + 8 * rg + 4 * hi) = wv; }
        if (hi == 0) WSP(float, WS_LSE)[((size_t)p * M + tq) * 8 + h] = mx + log2f(den);
        __syncthreads();
    }
}

__device__ __forceinline__ void combine_phase(const Ctx& C0) {
    const Ctx C = rectx(C0);
    const int gtid = C.bx * NTHREADS + C.tid, NT = C.G * NTHREADS;
    bf16_t* Y = WSP(bf16_t, WS_Y); const bf16_t* O1 = WSP(const bf16_t, WS_H); const bf16_t* O2 = O1 + (size_t)M * 512; const float* lse = WSP(const float, WS_LSE);
    for (int i = gtid; i < M * 64; i += NT) { const int row = i >> 6, c8 = i & 63, h = c8 >> 3;
        const float l0 = lse[(size_t)row * 8 + h], l1 = lse[((size_t)M + row) * 8 + h], l2 = lse[((size_t)2 * M + row) * 8 + h];
        const float mx = fmaxf(l0, fmaxf(l1, l2)); float w0 = fast_exp2(l0 - mx), w1 = fast_exp2(l1 - mx), w2 = fast_exp2(l2 - mx); const float rs = 1.0f / (w0 + w1 + w2); w0 *= rs; w1 *= rs; w2 *= rs;
        u32x4* yp = (u32x4*)(Y + (size_t)row * Y_W + c8 * 8);
        const u32x4 a = *yp, b = *(const u32x4*)(O1 + (size_t)row * 512 + c8 * 8), c = *(const u32x4*)(O2 + (size_t)row * 512 + c8 * 8);
        u32x4 o;
        o.x = pk2(w0 * bf_lo(a.x) + w1 * bf_lo(b.x) + w2 * bf_lo(c.x), w0 * bf_hi(a.x) + w1 * bf_hi(b.x) + w2 * bf_hi(c.x));
        o.y = pk2(w0 * bf_lo(a.y) + w1 * bf_lo(b.y) + w2 * bf_lo(c.y), w0 * bf_hi(a.y) + w1 * bf_hi(b.y) + w2 * bf_hi(c.y));
        o.z = pk2(w0 * bf_lo(a.z) + w1 * bf_lo(b.z) + w2 * bf_lo(c.z), w0 * bf_hi(a.z) + w1 * bf_hi(b.z) + w2 * bf_hi(c.z));
        o.w = pk2(w0 * bf_lo(a.w) + w1 * bf_lo(b.w) + w2 * bf_lo(c.w), w0 * bf_hi(a.w) + w1 * bf_hi(b.w) + w2 * bf_hi(c.w));
        *yp = o; }
}

__device__ __forceinline__ void diff_unit(const Ctx& C, int l, int b, int h, int qb) {
    const bf16_t* proj = WSP(const bf16_t, WS_PROJ);
    LAS float* tbl = (LAS float*)(C.lds + 65536);
    const int lane = C.lane, r32 = lane & 31, hi = lane >> 5, w = C.wave, comp = w >> 2, wq = w & 3;
    const int vlane = ((lane >> 4) & 1) * 32 + (lane & 3) * 8 + (4 * hi + ((lane & 15) >> 2)) * 64;
    const size_t tokbase = (size_t)b * SEQ; const int q0 = qb * 128;
    const int nkt = 2 * (qb + 1);
    for (int i = C.tid; i < 4224; i += NTHREADS) tbl[i] = WSP(const float, WS_TBLB)[h * 4224 + i];
    u32x4 kreg[2], vreg[2];
#define DIFF_LOAD(kt) do { _Pragma("unroll") for (int i_ = 0; i_ < 2; ++i_) { const int idx = C.tid + 512 * i_; \
        { const int cp = idx >> 9, chunk = (idx & 511) >> 6, key = idx & 63; kreg[i_] = *(const u32x4*)(proj + (tokbase + (size_t)(kt) * 64 + key) * PROJ_W + C_KB + h * 128 + cp * 64 + chunk * 8); } \
        { const int dblk = idx >> 8, ks = (idx & 255) >> 6, k16 = (idx & 63) >> 2, c4 = idx & 3; vreg[i_] = *(const u32x4*)(proj + (tokbase + (size_t)(kt) * 64 + ks * 16 + k16) * PROJ_W + C_VB + h * 128 + dblk * 32 + c4 * 8); } } } while (0)
#define DIFF_STORE(buf) do { _Pragma("unroll") for (int i_ = 0; i_ < 2; ++i_) { const int idx = C.tid + 512 * i_; \
        *(LAS u32x4*)(C.lds + (buf) * 32768 + idx * 16) = kreg[i_]; *(LAS u32x4*)(C.lds + (buf) * 32768 + 16384 + idx * 16) = vreg[i_]; } } while (0)
    DIFF_LOAD(0);
    const int qrow = q0 + 32 * wq + r32;
    bf16x8 qf[4];
#pragma unroll
    for (int d0 = 0; d0 < 4; ++d0) qf[d0] = *(const bf16x8*)(proj + (tokbase + qrow) * PROJ_W + C_QB + h * 128 + comp * 64 + d0 * 16 + hi * 8);
    DIFF_STORE(0);
    __syncthreads();
    f32x16 o[4]; o[0] = (f32x16){}; o[1] = (f32x16){}; o[2] = (f32x16){}; o[3] = (f32x16){};
    float mrun = NEGBIG, lrun = 0.f;
#pragma unroll 1
    for (int kt = 0; kt < nkt; ++kt) {
        const int buf = kt & 1;
        if (kt + 1 < nkt) DIFF_LOAD(kt + 1);
        const LAS unsigned char* Kc = C.lds + buf * 32768 + comp * 8192;
        const LAS unsigned char* Vc = C.lds + buf * 32768 + 16384;
        f32x16 S0, S1;
        {
            const LAS float* tb1 = tbl + (qrow - 64 * kt + 128 - 4 * hi - 27 - 32);
#pragma unroll
            for (int rg = 0; rg < 16; ++rg) { S0[rg] = tb1[32 + 27 - ((rg & 3) + 8 * (rg >> 2))]; S1[rg] = tb1[27 - ((rg & 3) + 8 * (rg >> 2))]; }
#pragma unroll
            for (int d0 = 0; d0 < 4; ++d0) {
                const bf16x8 k0 = *(const LAS bf16x8*)(Kc + (2 * d0 + hi) * 1024 + r32 * 16);
                const bf16x8 k1 = *(const LAS bf16x8*)(Kc + (2 * d0 + hi) * 1024 + (32 + r32) * 16);
                S0 = __builtin_amdgcn_mfma_f32_32x32x16_bf16(k0, qf[d0], S0, 0, 0, 0);
                S1 = __builtin_amdgcn_mfma_f32_32x32x16_bf16(k1, qf[d0], S1, 0, 0, 0);
            }
        }
        float mx = NEGBIG;
#pragma unroll
        for (int rg = 0; rg < 16; ++rg) mx = fmaxf(mx, fmaxf(S0[rg], S1[rg]));
        mx = fmaxf(mx, shx(mx, 32, C.lane));
        const float mnew = fmaxf(mrun, mx);
        if (__any(mnew > mrun)) {
            const float alpha = fast_exp2(mrun - mnew);
            lrun *= alpha;
#pragma unroll
            for (int d = 0; d < 4; ++d)
#pragma unroll
                for (int rg = 0; rg < 16; ++rg) o[d][rg] *= alpha;
            mrun = mnew;
        }
        float ps = 0.f;
#pragma unroll
        for (int rg = 0; rg < 16; ++rg) { S0[rg] = fast_exp2(S0[rg] - mrun); S1[rg] = fast_exp2(S1[rg] - mrun); ps += S0[rg] + S1[rg]; }
        lrun += ps;
#pragma unroll
        for (int kk = 0; kk < 2; ++kk)
#pragma unroll
            for (int s16 = 0; s16 < 2; ++s16) { const int ksg = 2 * kk + s16; const bf16x8 pf = pfrag(kk ? S1 : S0, s16);
#pragma unroll
                for (int dblk = 0; dblk < 4; ++dblk) { const bf16x8 vf = vfrag(Vc + dblk * 4096 + ksg * 1024 + vlane);
                    o[dblk] = __builtin_amdgcn_mfma_f32_32x32x16_bf16(vf, pf, o[dblk], 0, 0, 0); } }
        if (kt + 1 < nkt) DIFF_STORE(buf ^ 1);
        __syncthreads();
    }
#undef DIFF_LOAD
#undef DIFF_STORE
    lrun += shx(lrun, 32, C.lane);
    const float rl = 1.0f / lrun;
    const float lam = WSP(const float, WS_LAM)[l];
    const float lam_init = 0.8f - 0.6f * expf(-0.3f * (float)l);
    LAS float* ex = (LAS float*)(C.lds + wq * 16384);
    if (comp == 1) {
#pragma unroll
        for (int dblk = 0; dblk < 4; ++dblk)
#pragma unroll
            for (int rg = 0; rg < 16; ++rg) ex[(32 * dblk + crow(rg, hi)) * 32 + r32] = o[dblk][rg] * rl * lam;
    }
    __syncthreads();
    if (comp == 0) {
        float ss = 0.f;
#pragma unroll
        for (int dblk = 0; dblk < 4; ++dblk)
#pragma unroll
            for (int rg = 0; rg < 16; ++rg) { const float v = o[dblk][rg] * rl - ex[(32 * dblk + crow(rg, hi)) * 32 + r32]; o[dblk][rg] = v; ss += v * v; }
        ss += shx(ss, 32, C.lane);
        const float rs = (1.0f - lam_init) / sqrtf(ss * (1.0f / 128.0f) + EPS);
        const float* sg = C.in[I_SUBLN] + l * 128;
        bf16_t* yrow = WSP(bf16_t, WS_Y) + (tokbase + qrow) * Y_W + 512 + h * 128;
#pragma unroll
        for (int dblk = 0; dblk < 4; ++dblk)
#pragma unroll
            for (int rg = 0; rg < 4; ++rg) { const int d = 32 * dblk + 8 * rg + 4 * hi; const f32x4 g = *(const f32x4*)(sg + d);
                u32x2 wv; wv.x = pk2(o[dblk][4 * rg] * rs * g.x, o[dblk][4 * rg + 1] * rs * g.y); wv.y = pk2(o[dblk][4 * rg + 2] * rs * g.z, o[dblk][4 * rg + 3] * rs * g.w);
                *(u32x2*)(yrow + d) = wv; }
    }
    __syncthreads();
}
__device__ __forceinline__ void diff_phase(const Ctx& C0, int l) {
    const Ctx C = rectx(C0);
    for (int pi = C.vcu; pi < 256; pi += C.G) {
        const int bh = pi >> 4, j = pi & 15;
        diff_unit(C, l, bh >> 2, bh & 3, 31 - j);
        diff_unit(C, l, bh >> 2, bh & 3, j);
    }
}


#define XB_TMO      128
#define XB_XCNT(j)  (256  + 64 * (j))
#define XB_XSUB(j)  (1280 + 64 * (j))
#define XB_XGEN(j)  (2304 + 64 * (j))
#define XB_TOP      3328
#define XB_TOPGEN   3392
#define XCD_BAR_WORDS 3456
#define XB_SPIN_CAP (1u << 18)
__device__ __forceinline__ unsigned xb_ld(unsigned* p)              { return __hip_atomic_load(p, __ATOMIC_RELAXED, __HIP_MEMORY_SCOPE_AGENT); }
__device__ __forceinline__ unsigned xb_add(unsigned* p, unsigned v) { return __hip_atomic_fetch_add(p, v, __ATOMIC_RELAXED, __HIP_MEMORY_SCOPE_AGENT); }
__device__ __forceinline__ unsigned xb_xcc_id() { return (unsigned)__builtin_amdgcn_s_getreg((3 << 11) | 20) & 0xFu; }
#define XB_SPIN(cond, bar) do { unsigned _sp = 0; while (cond) { __builtin_amdgcn_s_sleep(1); \
    if ((++_sp & 255u) == 0u) { if (xb_ld(&(bar)[XB_TMO])) break; if (_sp > XB_SPIN_CAP) { atomicAdd(&(bar)[XB_TMO], 1u); break; } } } } while (0)
struct XcdBarrier { unsigned* bar; unsigned x; volatile LAS unsigned* st; };
__device__ __forceinline__ XcdBarrier xcd_barrier_post(unsigned* bar, volatile LAS unsigned* st) {
    XcdBarrier b; b.bar = bar; b.x = xb_xcc_id(); b.st = st;
    if (threadIdx.x == 0) (void)xb_add(&bar[XB_XCNT(b.x)], 1u);
    return b;
}
__device__ __forceinline__ void xcd_barrier_complete(unsigned* bar, unsigned x, unsigned& nloc, unsigned& nx) {
    const unsigned G = gridDim.x * gridDim.y * gridDim.z;
    unsigned sum, cnt, mine, sp = 0u;
    for (;;) {
        sum = 0u; cnt = 0u; mine = 0u;
#pragma unroll
        for (unsigned j = 0; j < 16; ++j) { const unsigned c = xb_ld(&bar[XB_XCNT(j)]); sum += c; cnt += (c > 0u) ? 1u : 0u; mine = (j == x) ? c : mine; }
        if (sum == G) break;
        __builtin_amdgcn_s_sleep(1);
        if ((++sp & 255u) == 0u) { if (xb_ld(&bar[XB_TMO])) break; if (sp > XB_SPIN_CAP) { atomicAdd(&bar[XB_TMO], 1u); break; } }
    }
    nloc = mine > 0u ? mine : 1u; nx = cnt > 0u ? cnt : 1u;
}
__device__ __forceinline__ void xcd_barrier(const XcdBarrier& b) {
    asm volatile("s_waitcnt vmcnt(0)" ::: "memory");
    __syncthreads();
    if (threadIdx.x == 0) {
        unsigned* bar = b.bar;
        __builtin_amdgcn_s_waitcnt(0);
        unsigned nloc = b.st[0], nx = b.st[1];
        if (nloc == 0u) { xcd_barrier_complete(bar, b.x, nloc, nx); b.st[0] = nloc; b.st[1] = nx; }
        const unsigned old = xb_add(&bar[XB_XSUB(b.x)], 1u);
        const unsigned gen = old / nloc;
        if (old + 1u == (gen + 1u) * nloc) {
            __builtin_amdgcn_fence(__ATOMIC_RELEASE, "agent");
            asm volatile("s_waitcnt vmcnt(0)" ::: "memory");
            const unsigned og = xb_add(&bar[XB_TOP], 1u);
            const unsigned tg = og / nx;
            if (og + 1u == (tg + 1u) * nx) xb_add(&bar[XB_TOPGEN], 1u);
            else XB_SPIN(xb_ld(&bar[XB_TOPGEN]) == tg, bar);
            __builtin_amdgcn_fence(__ATOMIC_ACQUIRE, "agent");
            xb_add(&bar[XB_XGEN(b.x)], 1u);
            asm volatile("s_waitcnt vmcnt(0)" ::: "memory");
        } else {
            XB_SPIN(xb_ld(&bar[XB_XGEN(b.x)]) == gen, bar);
            __builtin_amdgcn_fence(__ATOMIC_ACQUIRE, "agent");
            asm volatile("s_waitcnt vmcnt(0)" ::: "memory");
        }
    }
    __syncthreads();
}
constexpr int LDS_BARST = 131072 + 512;

__global__ void __launch_bounds__(NTHREADS, 2) fwd_megakernel(Params P) {
    extern __shared__ __attribute__((aligned(16))) unsigned char lds_raw[];
    cg::grid_group grid = cg::this_grid();
    Ctx CB;
    CB.lds = (LAS unsigned char*)lds_raw;
    CB.tid = 0; CB.lane = 0; CB.wave = 0;
    CB.G = gridDim.x; CB.bx = blockIdx.x; CB.vcu = (CB.G % 8 == 0) ? (CB.bx % 8) * (CB.G / 8) + CB.bx / 8 : CB.bx;
    CB.in = P.in; CB.out = P.out; CB.ws = P.ws;

    unsigned* barw = (unsigned*)(P.ws + WS_CTL);
    if (blockIdx.x == 0) for (int i = threadIdx.x; i < XCD_BAR_WORDS; i += NTHREADS) __hip_atomic_store(barw + i, 0u, __ATOMIC_RELAXED, __HIP_MEMORY_SCOPE_AGENT);
    volatile LAS unsigned* barst = (volatile LAS unsigned*)(CB.lds + LDS_BARST);
    if (threadIdx.x < 2) barst[threadIdx.x] = 0u;
    __syncthreads();
    XcdBarrier xbar; xbar.bar = barw; xbar.x = 0; xbar.st = barst;
    constexpr int NSTEP = 14;
#pragma unroll 1
    for (int step = 0; step < DEPTH * NSTEP; ++step) {
        const int l = step / NSTEP, s = step - l * NSTEP;
        const Ctx C = rectx(CB);
        const float* modl = WSP(const float, WS_MOD) + (size_t)l * 4 * 9216;
        switch (s) {
        case 0: if (l == 0) prologue_misc(C); convert_weights(C, l); break;
        case 1: norm_phase(C, l, 0); break;
        case 4: norm_phase(C, l, 1); break;
        case 11: norm_phase(C, l, 2); break;
        case 2: case 12: {
            const int f = (s == 12);
            pg8::Gemm g{WSP(const bf16_t, WS_H), WSP(const bf16_t, f ? W_UP1 : W_UP0), DM, DM, DM, 0, 0};
            pg8::TileOrder S; S.init(M, NUP, C.G, C.bx, 1);
            pg8::EpiSwiGLU E{WSP(bf16_t, WS_PROJ)};
            pg8::gemm_phase(C.lds, g, S, E);
        } break;
        case 3: case 13: {
            const int f = (s == 13);
            pg8::Gemm g{WSP(const bf16_t, WS_PROJ), WSP(const bf16_t, f ? W_DN1 : W_DN0), DFF, DFF, DFF, 0, 0};
            pg8::TileOrder S; S.init(M, DM, C.G, C.bx, 1);
            pg8::EpiResidual E{C.out, modl + (f ? 8 : 2) * 1024, 0.5f};
            pg8::gemm_phase(C.lds, g, S, E);
        } break;
        case 5: {
            pg8::Gemm g{WSP(const bf16_t, WS_H), WSP(const bf16_t, W_IN), DM, DM, DM, 0, 0};
            pg8::TileOrder S; S.init(M, NIN, C.G, C.bx, 1);
            pg8::EpiInGate E{WSP(bf16_t, WS_PROJ), WSP(bf16_t, WS_GATES), C.in[I_BGATE] + (size_t)l * GATE_W};
            pg8::gemm_phase(C.lds, g, S, E);
        } break;
        case 6: qknorm_phase(C, l); conv_phase(C, l); break;
        case 7: dilated_phase(C); break;
        case 8: combine_phase(C); diff_phase(C, l); break;
        case 9: {
            pg8::Gemm g{WSP(const bf16_t, WS_Y), WSP(const bf16_t, W_BR), Y_W, 512, 512, 512, (long)DM * 512};
            pg8::TileOrder S; S.init(M, DM, C.G, C.bx, 3);
            pg8::EpiBranch E{WSP(const bf16_t, WS_GATES), WSP(float, WS_PROJ), WSP(bf16_t, WS_H)};
            pg8::gemm_phase(C.lds, g, S, E);
        } break;
        case 10: {
            pg8::Gemm g{WSP(const bf16_t, WS_H), WSP(const bf16_t, W_OUT), DM, DM, DM, 0, 0};
            pg8::TileOrder S; S.init(M, DM, C.G, C.bx, 1);
            pg8::EpiResidual E{C.out, modl + 5 * 1024, 1.0f};
            pg8::gemm_phase(C.lds, g, S, E);
        } break;
        default: break;
        }
        if (step == 0) { grid.sync(); xbar = xcd_barrier_post(barw, barst); }
        else if (step + 1 < DEPTH * NSTEP) xcd_barrier(xbar);
    }
}

extern "C" void kernel_launch(void* const* d_in, const int* in_sizes, int n_in, void* d_out, int out_size, void* d_ws, size_t ws_size, hipStream_t stream) {
    static int grid = 0;
    if (grid == 0) {
        int dev = 0, cus = 0, per_cu = 0;
        if (n_in != 20 || out_size != M * DM || ws_size < WS_END) { fprintf(stderr, "kernel_launch: unexpected problem shape (n_in %d out %d ws %zu)\n", n_in, out_size, ws_size); grid = -1; return; }
        hipGetDevice(&dev);
        hipDeviceGetAttribute(&cus, hipDeviceAttributeMultiprocessorCount, dev);
        hipFuncSetAttribute((const void*)fwd_megakernel, hipFuncAttributeMaxDynamicSharedMemorySize, LDS_BYTES);
        hipOccupancyMaxActiveBlocksPerMultiprocessor(&per_cu, (const void*)fwd_megakernel, NTHREADS, LDS_BYTES);
        (void)hipGetLastError();
        if (per_cu < 1) { fprintf(stderr, "kernel_launch: occupancy query says %d blocks per CU\n", per_cu); per_cu = 1; }
        grid = cus;
    }
    if (grid < 0) return;
    Params p{};
    for (int i = 0; i < 20; ++i) p.in[i] = (const float*)d_in[i];
    p.out = (float*)d_out; p.ws = (unsigned char*)d_ws; p.dbg = 0; p.pad = 0;
    void* args[] = {&p};
    hipError_t e = hipLaunchCooperativeKernel((const void*)fwd_megakernel, dim3(grid), dim3(NTHREADS), args, LDS_BYTES, stream);
    if (e != hipSuccess) fprintf(stderr, "cooperative launch failed: %s (grid %d)\n", hipGetErrorString(e), grid);
}
```

```cpp
#include <hip/hip_runtime.h>
#include <hip/hip_cooperative_groups.h>
#include <cstdint>
#include <cstdio>
namespace cg = cooperative_groups;

#define LAS __attribute__((address_space(3)))
typedef unsigned short bf16_t;
typedef short bf16x8 __attribute__((ext_vector_type(8)));
typedef short s16x4 __attribute__((ext_vector_type(4)));
typedef float f32x2 __attribute__((ext_vector_type(2)));
typedef float f32x4 __attribute__((ext_vector_type(4)));
typedef float f32x16 __attribute__((ext_vector_type(16)));
typedef unsigned u32x2 __attribute__((ext_vector_type(2)));
typedef unsigned u32x4 __attribute__((ext_vector_type(4)));
typedef __bf16 bf16x2_t __attribute__((ext_vector_type(2)));

constexpr int BATCH = 4, SEQ = 4096, DM = 1024, M = BATCH * SEQ, DEPTH = 2;
constexpr int DFF = 2816, NUP = 2 * DFF;
constexpr int PROJ_W = 3584;
constexpr int GATE_W = 3072, Y_W = 1536, NIN = 7168;
constexpr int C_QA = 0, C_KA = 512, C_VA = 1024, C_QB = 1536, C_KB = 2048, C_VB = 2560, C_U = 3072;
constexpr float LOG2E = 1.4426950408889634f;
constexpr float QSCALE = 0.125f * LOG2E;
constexpr float NEGBIG = -1e30f;
constexpr float EPS = 1e-6f;

constexpr size_t MiB = 1u << 20;
constexpr size_t WS_CTL = 0;
constexpr size_t WS_MOD = 1 * MiB;
constexpr size_t WS_TBLA = WS_MOD + 512 * 1024;
constexpr size_t WS_TBLB = WS_TBLA + 32 * 1024;
constexpr size_t WS_LAM = WS_TBLB + 128 * 1024;
constexpr size_t WS_W = 2 * MiB;
constexpr size_t W_UP0 = WS_W, W_DN0 = W_UP0 + (size_t)NUP * DM * 2, W_UP1 = W_DN0 + (size_t)DM * DFF * 2, W_DN1 = W_UP1 + (size_t)NUP * DM * 2;
constexpr size_t W_IN = W_DN1 + (size_t)DM * DFF * 2, W_BR = W_IN + (size_t)NIN * DM * 2, W_OUT = W_BR + (size_t)3 * DM * 512 * 2;
constexpr size_t WS_H = 54 * MiB;
constexpr size_t WS_PROJ = 86 * MiB;
constexpr size_t WS_GATES = 198 * MiB;
constexpr size_t WS_Y = 294 * MiB;
constexpr size_t WS_LSE = 342 * MiB;
constexpr size_t WS_END = 344 * MiB;
static_assert(W_OUT + (size_t)DM * DM * 2 <= WS_H, "weights fit");

constexpr int LDS_BYTES = 147456;
constexpr int NTHREADS = 512;

struct Params { const float* in[20]; float* out; unsigned char* ws; int dbg; int pad; };
enum { I_X = 0, I_C, I_RELB, I_WADA, I_BADA, I_NORMG, I_WFFIN, I_WFFOUT, I_WIN, I_QKG, I_LAMV, I_SUBLN, I_CONVW, I_CONVB, I_CLNG, I_CLNB, I_WBR, I_WGATE, I_BGATE, I_WOUT };

__device__ __forceinline__ unsigned pk2(float lo, float hi) { f32x2 v = {lo, hi}; bf16x2_t b = __builtin_convertvector(v, bf16x2_t); return __builtin_bit_cast(unsigned, b); }
__device__ __forceinline__ float bf_lo(unsigned w) { return __uint_as_float(w << 16); }
__device__ __forceinline__ float bf_hi(unsigned w) { return __uint_as_float(w & 0xffff0000u); }
__device__ __forceinline__ float shx(float v, int m, int lane) { return __int_as_float(__builtin_amdgcn_ds_bpermute((lane ^ m) << 2, __float_as_int(v))); }
__device__ __forceinline__ float wave_sum(float v, int lane) {
#pragma unroll
    for (int o = 1; o < 64; o <<= 1) v += shx(v, o, lane);
    return v;
}
__device__ __forceinline__ float fast_exp2(float x) { return __builtin_amdgcn_exp2f(x); }
__device__ __forceinline__ float sigmoidf_(float x) { return __builtin_amdgcn_rcpf(1.0f + fast_exp2(-x * LOG2E)); }
__device__ __forceinline__ float siluf_(float x) { return x * sigmoidf_(x); }
__device__ __forceinline__ int crow(int r, int hi) { return (r & 3) + 8 * (r >> 2) + 4 * hi; }
__device__ __forceinline__ int t5_bucket(int d) {
    if (d < 16) return d;
    const int thr[15] = {22, 30, 40, 54, 73, 99, 134, 182, 246, 332, 450, 609, 825, 1117, 1513};
    int b = 16;
#pragma unroll
    for (int i = 0; i < 15; ++i) b += (d >= thr[i]) ? 1 : 0;
    return b;
}

namespace pg8 {
constexpr int BM = 256, BK = 64, HALF = 128, HTB = HALF * BK * 2, NXCD = 8, WGM = 8;
__host__ __device__ __forceinline__ int lds_byte(int r, int c) { const int st = (r >> 4) * 2 + (c >> 5), rr = r & 15, cc = c & 31, ob = rr * 64 + cc * 2; return st * 1024 + (ob ^ (((ob >> 9) & 1) << 5)); }
__host__ __device__ __forceinline__ void stage_rc(int b, int& R, int& C) { const int st = b / 1024, sb = b % 1024, swz = sb ^ (((sb >> 9) & 1) << 5); R = (st >> 1) * 16 + swz / 64; C = (st & 1) * 32 + (swz % 64) / 2; }
__host__ __device__ __forceinline__ int perm32(int rho) { const int n = rho >> 4, i = rho & 15; return 8 * (i >> 2) + 4 * n + (i & 3); }

struct Unit { int pm, pn, z; };
struct Gemm { const bf16_t* A; const bf16_t* Bt; int lda, ldb, K; long zA, zB; };

struct TileOrder {
    int nM, nN, nwg, G, c, zn;
    __device__ void init(int Mrows, int N, int G_, int c_, int zn_) { nM = Mrows / BM; nN = N / BM; nwg = nM * nN; G = G_; c = c_; zn = zn_; }
    __device__ bool next(int i, Unit& u) const {
        const int ti = i / zn; u.z = i - ti * zn;
        const long L = (long)ti * G + c; if (L >= nwg) return false;
        int wgid = (int)L; { const int q = nwg / NXCD, r = nwg % NXCD, xcd = wgid % NXCD, off = wgid / NXCD; wgid = (xcd < r ? xcd * (q + 1) : r * (q + 1) + (xcd - r) * q) + off; }
        const int nig = WGM * nN, gid = wgid / nig, fm = gid * WGM, gsz = (nM - fm) < WGM ? (nM - fm) : WGM;
        u.pm = fm + ((wgid % nig) % gsz); u.pn = (wgid % nig) / gsz; return true;
    }
};

template <class Epi>
__device__ __forceinline__ void gemm_phase(LAS unsigned char* lds, const Gemm g, const TileOrder& S, const Epi& E) {
    int tid = threadIdx.x; asm volatile("" : "+v"(tid));
    const int wid = __builtin_amdgcn_readfirstlane(tid >> 6), lane = tid & 63, wr = wid >> 2, wc = wid & 3, fr = lane & 15, fq = lane >> 4;
    const int K = g.K, nt = K / BK;
    unsigned voffA[2], voffB[2];
#pragma unroll
    for (int i = 0; i < 2; ++i) { int R, C; stage_rc(tid * 16 + i * 8192, R, C); const int Rb = Epi::PERM ? ((R & ~31) + perm32(R & 31)) : R;
        voffA[i] = (unsigned)(R * g.lda + C) * 2u; voffB[i] = (unsigned)(Rb * g.ldb + C) * 2u; }
    const size_t kstep = (size_t)(BK * 2);
    const size_t hstepA = (size_t)HALF * g.lda * 2, hstepB = (size_t)HALF * g.ldb * 2;
    const size_t tstepA = 2 * hstepA, tstepB = 2 * hstepB;
    const unsigned ldsw = (unsigned)wid * 1024u;
    const int aoff = lds_byte(wr * 64 + fr, fq * 8), boff = lds_byte(wc * 32 + fr, fq * 8);
#define PG8_SA(b, h) (((b) * 2 + (h)) * HTB)
#define PG8_SB(b, h) ((4 + (b) * 2 + (h)) * HTB)
#define PG8_STAGE(bufoff, gbase, voff) do { _Pragma("unroll") for (int _i = 0; _i < 2; ++_i) \
        __builtin_amdgcn_global_load_lds((const unsigned*)((const char*)(gbase) + (voff)[_i]), (LAS unsigned*)(lds + (bufoff) + ldsw + _i * 8192), 16, 0, 0); } while (0)
#define PG8_LDA(dst, b, h) do { _Pragma("unroll") for (int m = 0; m < 4; ++m) _Pragma("unroll") for (int k = 0; k < 2; ++k) dst[m][k] = *(const LAS bf16x8*)(lds + PG8_SA(b, h) + aoff + m * 2048 + k * 1024); } while (0)
#define PG8_LDB(dst, b, h) do { _Pragma("unroll") for (int n = 0; n < 2; ++n) _Pragma("unroll") for (int k = 0; k < 2; ++k) dst[n][k] = *(const LAS bf16x8*)(lds + PG8_SB(b, h) + boff + n * 2048 + k * 1024); } while (0)
#define PG8_MMA(ai, bj, At, Bt) do { __builtin_amdgcn_s_setprio(1); _Pragma("unroll") for (int m = 0; m < 4; ++m) _Pragma("unroll") for (int n = 0; n < 2; ++n) _Pragma("unroll") for (int k = 0; k < 2; ++k) \
        acc[ai][bj][m][n] = __builtin_amdgcn_mfma_f32_16x16x32_bf16(Bt[n][k], At[m][k], acc[ai][bj][m][n], 0, 0, 0); __builtin_amdgcn_s_setprio(0); } while (0)
#define PG8_WAIT_V(n) asm volatile("s_waitcnt vmcnt(" #n ")" ::: "memory")
#define PG8_WAIT_L(n) asm volatile("s_waitcnt lgkmcnt(" #n ")" ::: "memory")
#define PG8_BAR __builtin_amdgcn_s_barrier()
#define PG8_SCHED __builtin_amdgcn_sched_barrier(0)
    Unit cur, nxt; int ui = 0;
    if (!S.next(0, cur)) return;
    f32x4 acc[2][2][4][2];
#pragma unroll
    for (int a = 0; a < 2; ++a)
#pragma unroll
        for (int b = 0; b < 2; ++b)
#pragma unroll
            for (int m = 0; m < 4; ++m)
#pragma unroll
                for (int n = 0; n < 2; ++n) acc[a][b][m][n] = (f32x4){0.f, 0.f, 0.f, 0.f};
    bf16x8 At[4][2], B0[2][2], B1[2][2];
    const char* cA = (const char*)g.A + (size_t)cur.pm * tstepA + (size_t)cur.z * g.zA * 2; const char* cB = (const char*)g.Bt + (size_t)cur.pn * tstepB + (size_t)cur.z * g.zB * 2;
    PG8_STAGE(PG8_SB(0, 0), cB, voffB); PG8_STAGE(PG8_SB(0, 1), cB + hstepB, voffB); PG8_STAGE(PG8_SA(0, 0), cA, voffA); PG8_STAGE(PG8_SA(0, 1), cA + hstepA, voffA);
    if (wr == 1) PG8_BAR;
    PG8_WAIT_V(2); PG8_BAR;
    PG8_STAGE(PG8_SB(1, 0), cB + kstep, voffB); PG8_STAGE(PG8_SA(1, 0), cA + kstep, voffA); PG8_STAGE(PG8_SB(1, 1), cB + hstepB + kstep, voffB);
    PG8_WAIT_V(6); PG8_BAR;
    for (;;) {
        const bool has_next = S.next(ui + 1, nxt);
        const char* nA = has_next ? (const char*)g.A + (size_t)nxt.pm * tstepA + (size_t)nxt.z * g.zA * 2 : cA; const char* nB = has_next ? (const char*)g.Bt + (size_t)nxt.pn * tstepB + (size_t)nxt.z * g.zB * 2 : cB;
        for (int t = 0; t < nt; t += 2) {
            const bool last = (t == nt - 2);
            const char* a1 = cA + (size_t)(t + 1) * kstep;
            const char* a2 = last ? nA : cA + (size_t)(t + 2) * kstep; const char* b2 = last ? nB : cB + (size_t)(t + 2) * kstep;
            const char* a3 = a2 + kstep; const char* b3 = b2 + kstep;
            PG8_LDB(B0, 0, 0); PG8_LDB(B1, 0, 1); PG8_SCHED; PG8_LDA(At, 0, 0); PG8_STAGE(PG8_SA(1, 1), a1 + hstepA, voffA);
            PG8_WAIT_V(8); PG8_WAIT_L(0); PG8_BAR; PG8_MMA(0, 0, At, B0); PG8_MMA(0, 1, At, B1); PG8_BAR; PG8_SCHED;
            PG8_LDA(At, 0, 1); PG8_STAGE(PG8_SB(0, 0), b2, voffB); PG8_STAGE(PG8_SB(0, 1), b2 + hstepB, voffB); PG8_STAGE(PG8_SA(0, 0), a2, voffA);
            PG8_WAIT_V(8); PG8_WAIT_L(0); PG8_BAR; PG8_MMA(1, 0, At, B0); PG8_MMA(1, 1, At, B1); PG8_BAR; PG8_SCHED;
            PG8_LDB(B0, 1, 0); PG8_LDB(B1, 1, 1); PG8_SCHED; PG8_LDA(At, 1, 0); PG8_STAGE(PG8_SA(0, 1), a2 + hstepA, voffA);
            PG8_WAIT_V(8); PG8_WAIT_L(0); PG8_BAR; PG8_MMA(0, 0, At, B0); PG8_MMA(0, 1, At, B1); PG8_BAR; PG8_SCHED;
            PG8_LDA(At, 1, 1); PG8_STAGE(PG8_SB(1, 0), b3, voffB); PG8_STAGE(PG8_SB(1, 1), b3 + hstepB, voffB); PG8_STAGE(PG8_SA(1, 0), a3, voffA);
            PG8_WAIT_V(8); PG8_WAIT_L(0); PG8_BAR; PG8_MMA(1, 0, At, B0); PG8_MMA(1, 1, At, B1); PG8_BAR; PG8_SCHED;
        }
        if (wr == 0) PG8_BAR;
        E(acc, cur, wr, wc, fr, fq);
        if (!has_next) break;
#pragma unroll
        for (int a = 0; a < 2; ++a)
#pragma unroll
            for (int b = 0; b < 2; ++b)
#pragma unroll
                for (int m = 0; m < 4; ++m)
#pragma unroll
                    for (int n = 0; n < 2; ++n) acc[a][b][m][n] = (f32x4){0.f, 0.f, 0.f, 0.f};
        cur = nxt; cA = nA; cB = nB; ++ui;
        if (wr == 1) PG8_BAR;
    }
    PG8_WAIT_V(0);
    PG8_BAR;
#undef PG8_SA
#undef PG8_SB
#undef PG8_STAGE
#undef PG8_LDA
#undef PG8_LDB
#undef PG8_MMA
#undef PG8_WAIT_V
#undef PG8_WAIT_L
#undef PG8_BAR
#undef PG8_SCHED
}

__device__ __forceinline__ u32x4 pack8(const f32x4 a, const f32x4 b) { u32x4 w; w.x = pk2(a[0], a[1]); w.y = pk2(a[2], a[3]); w.z = pk2(b[0], b[1]); w.w = pk2(b[2], b[3]); return w; }

struct EpiSwiGLU {
    static constexpr bool PERM = true;
    bf16_t* O;
    __device__ __forceinline__ void operator()(const f32x4 (&acc)[2][2][4][2], const Unit& u, int wr, int wc, int fr, int fq) const {
        const int row0 = u.pm * BM + wr * 64 + fr, col0 = u.pn * HALF + wc * 32 + 8 * fq;
#pragma unroll
        for (int ai = 0; ai < 2; ++ai)
#pragma unroll
            for (int m = 0; m < 4; ++m) {
                f32x4 h0, h1;
#pragma unroll
                for (int i = 0; i < 4; ++i) { h0[i] = siluf_(acc[ai][0][m][0][i]) * acc[ai][1][m][0][i]; h1[i] = siluf_(acc[ai][0][m][1][i]) * acc[ai][1][m][1][i]; }
                *(u32x4*)(O + (size_t)(row0 + ai * HALF + m * 16) * DFF + col0) = pack8(h0, h1);
            }
    }
};
struct EpiResidual {
    static constexpr bool PERM = false;
    const float* src; float* out; const float* gvec; float coef;
    __device__ __forceinline__ void operator()(const f32x4 (&acc)[2][2][4][2], const Unit& u, int wr, int wc, int fr, int fq) const {
        const int row0 = u.pm * BM + wr * 64 + fr, col0 = u.pn * BM + wc * 32 + 4 * fq; const int b = u.pm >> 4;
        f32x4 gv[2][2];
#pragma unroll
        for (int bj = 0; bj < 2; ++bj)
#pragma unroll
            for (int n = 0; n < 2; ++n) gv[bj][n] = *(const f32x4*)(gvec + (size_t)b * 9216 + col0 + bj * HALF + n * 16) * coef;
#pragma unroll
        for (int ai = 0; ai < 2; ++ai)
#pragma unroll
            for (int m = 0; m < 4; ++m) { float* rowp = out + (size_t)(row0 + ai * HALF + m * 16) * DM + col0; const float* srow = src + (size_t)(row0 + ai * HALF + m * 16) * DM + col0;
#pragma unroll
                for (int bj = 0; bj < 2; ++bj)
#pragma unroll
                    for (int n = 0; n < 2; ++n) { float* p = rowp + bj * HALF + n * 16; *(f32x4*)p = *(const f32x4*)(srow + bj * HALF + n * 16) + gv[bj][n] * acc[ai][bj][m][n]; } }
    }
};
struct EpiInGate {
    static constexpr bool PERM = true;
    bf16_t* proj; bf16_t* gates; const float* bgate;
    __device__ __forceinline__ void operator()(const f32x4 (&acc)[2][2][4][2], const Unit& u, int wr, int wc, int fr, int fq) const {
        const int row0 = u.pm * BM + wr * 64 + fr; const int cw = wc * 32 + 8 * fq;
        if (u.pn < 12) {
#pragma unroll
            for (int ai = 0; ai < 2; ++ai)
#pragma unroll
                for (int m = 0; m < 4; ++m) { bf16_t* rp = proj + (size_t)(row0 + ai * HALF + m * 16) * PROJ_W + u.pn * BM + cw;
#pragma unroll
                    for (int bj = 0; bj < 2; ++bj) *(u32x4*)(rp + bj * HALF) = pack8(acc[ai][bj][m][0], acc[ai][bj][m][1]); }
        } else if (u.pn < 16) {
#pragma unroll
            for (int ai = 0; ai < 2; ++ai)
#pragma unroll
                for (int m = 0; m < 4; ++m) { f32x4 h0, h1;
#pragma unroll
                    for (int i = 0; i < 4; ++i) { h0[i] = acc[ai][0][m][0][i] * sigmoidf_(acc[ai][1][m][0][i]); h1[i] = acc[ai][0][m][1][i] * sigmoidf_(acc[ai][1][m][1][i]); }
                    *(u32x4*)(proj + (size_t)(row0 + ai * HALF + m * 16) * PROJ_W + C_U + (u.pn - 12) * HALF + cw) = pack8(h0, h1); }
        } else {
            const int cb = (u.pn - 16) * BM + cw;
            f32x4 bv[2][2];
#pragma unroll
            for (int bj = 0; bj < 2; ++bj) { bv[bj][0] = *(const f32x4*)(bgate + cb + bj * HALF); bv[bj][1] = *(const f32x4*)(bgate + cb + bj * HALF + 4); }
#pragma unroll
            for (int ai = 0; ai < 2; ++ai)
#pragma unroll
                for (int m = 0; m < 4; ++m) { bf16_t* rp = gates + (size_t)(row0 + ai * HALF + m * 16) * GATE_W + cb;
#pragma unroll
                    for (int bj = 0; bj < 2; ++bj) { f32x4 h0, h1;
#pragma unroll
                        for (int i = 0; i < 4; ++i) { h0[i] = sigmoidf_(acc[ai][bj][m][0][i] + bv[bj][0][i]); h1[i] = sigmoidf_(acc[ai][bj][m][1][i] + bv[bj][1][i]); }
                        *(u32x4*)(rp + bj * HALF) = pack8(h0, h1); } }
        }
    }
};
struct EpiBranch {
    static constexpr bool PERM = true;
    const bf16_t* gates; bf16_t* merged;
    __device__ __forceinline__ void operator()(const f32x4 (&acc)[2][2][4][2], const Unit& u, int wr, int wc, int fr, int fq) const {
        const int row0 = u.pm * BM + wr * 64 + fr; const int cb = u.pn * BM + wc * 32 + 8 * fq; const int z = u.z;
#pragma unroll
        for (int ai = 0; ai < 2; ++ai)
#pragma unroll
            for (int m = 0; m < 4; ++m) { const size_t row = (size_t)(row0 + ai * HALF + m * 16);
#pragma unroll
                for (int bj = 0; bj < 2; ++bj) {
                    const u32x4 gw = *(const u32x4*)(gates + row * GATE_W + z * 1024 + cb + bj * HALF);
                    u32x4* mp = (u32x4*)(merged + row * DM + cb + bj * HALF);
                    f32x4 t0, t1;
                    t0[0] = bf_lo(gw.x) * acc[ai][bj][m][0][0]; t0[1] = bf_hi(gw.x) * acc[ai][bj][m][0][1]; t0[2] = bf_lo(gw.y) * acc[ai][bj][m][0][2]; t0[3] = bf_hi(gw.y) * acc[ai][bj][m][0][3];
                    t1[0] = bf_lo(gw.z) * acc[ai][bj][m][1][0]; t1[1] = bf_hi(gw.z) * acc[ai][bj][m][1][1]; t1[2] = bf_lo(gw.w) * acc[ai][bj][m][1][2]; t1[3] = bf_hi(gw.w) * acc[ai][bj][m][1][3];
                    if (z > 0) { const u32x4 pv = *mp;
                        t0[0] += bf_lo(pv.x); t0[1] += bf_hi(pv.x); t0[2] += bf_lo(pv.y); t0[3] += bf_hi(pv.y); t1[0] += bf_lo(pv.z); t1[1] += bf_hi(pv.z); t1[2] += bf_lo(pv.w); t1[3] += bf_hi(pv.w); }
                    *mp = pack8(t0, t1);
                } }
    }
};
}

struct Ctx {
    LAS unsigned char* lds;
    int tid, lane, wave, G, vcu, bx;
    const float* const* in;
    float* out; unsigned char* ws;
};
#define WSP(T, off) ((T*)(C.ws + (off)))
__device__ __forceinline__ Ctx rectx(const Ctx& C0) { Ctx C = C0; int t = threadIdx.x; asm volatile("" : "+v"(t)); C.tid = t; C.lane = t & 63; C.wave = __builtin_amdgcn_readfirstlane(t >> 6);
    int z = 0; asm volatile("" : "+s"(z)); C.G += z; C.bx += z; C.vcu += z; C.ws += z; C.out += z; C.in += z; C.lds += z; return C; }

__device__ __forceinline__ void transpose_item(const float* W, int ldw, int srccol0, int k0, bf16_t* WT, int K, int dstrow0, LAS float* scr, int lane) {
#pragma unroll 8
    for (int i = 0; i < 32; ++i) { const int kk = 2 * i + (lane >> 5); scr[kk * 33 + (lane & 31)] = W[(size_t)(k0 + kk) * ldw + srccol0 + (lane & 31)]; }
    asm volatile("s_waitcnt lgkmcnt(0)" ::: "memory");
    const int c = lane & 7;
#pragma unroll
    for (int j = 0; j < 4; ++j) { const int n = (lane >> 3) + 8 * j; const LAS float* s = scr + (8 * c) * 33 + n;
        u32x4 o; o.x = pk2(s[0 * 33], s[1 * 33]); o.y = pk2(s[2 * 33], s[3 * 33]); o.z = pk2(s[4 * 33], s[5 * 33]); o.w = pk2(s[6 * 33], s[7 * 33]);
        *(u32x4*)(WT + (size_t)(dstrow0 + n) * K + k0 + 8 * c) = o; }
    asm volatile("s_waitcnt lgkmcnt(0)" ::: "memory");
}
__device__ __forceinline__ int up_srccol(int n0) { const int tile = n0 >> 8, half = (n0 >> 7) & 1, j = n0 & 127; return half * DFF + tile * 128 + j; }
__device__ __forceinline__ int win_srccol(int n0) { if (n0 < 3072) return n0; const int t = (n0 - 3072) >> 8, half = ((n0 - 3072) >> 7) & 1, j = n0 & 127; return 3072 + half * 512 + t * 128 + j; }

__device__ __forceinline__ void convert_weights(const Ctx& C0, int l) {
    const Ctx C = rectx(C0);
    LAS float* scr = (LAS float*)(C.lds + C.wave * 16384);
    const int gw = C.vcu * 8 + C.wave, NGW = C.G * 8;
    constexpr int I_UP = (DM / 64) * (NUP / 32), I_DN = (DFF / 64) * (DM / 32), I_INA = (DM / 64) * (4096 / 32), I_INB = (DM / 64) * (3072 / 32), I_BRN = (512 / 64) * (DM / 32), I_OUTN = (DM / 64) * (DM / 32);
    constexpr int NITEMS = 2 * I_UP + 2 * I_DN + I_INA + I_INB + 3 * I_BRN + I_OUTN;
    const float* wffin = C.in[I_WFFIN] + (size_t)l * 2 * DM * NUP;
    const float* wffout = C.in[I_WFFOUT] + (size_t)l * 2 * DFF * DM;
    const float* win = C.in[I_WIN] + (size_t)l * DM * 4096;
    const float* wgate = C.in[I_WGATE] + (size_t)l * DM * 3072;
    const float* wbr = C.in[I_WBR] + (size_t)l * 3 * 512 * DM;
    const float* wout = C.in[I_WOUT] + (size_t)l * DM * DM;
    for (int it = gw; it < NITEMS; it += NGW) {
        int r = it;
        if (r < 2 * I_UP) { const int f = r / I_UP; r -= f * I_UP; const int nblk = NUP / 32, kb = r / nblk, nb = r % nblk;
            transpose_item(wffin + (size_t)f * DM * NUP, NUP, up_srccol(nb * 32), kb * 64, WSP(bf16_t, f ? W_UP1 : W_UP0), DM, nb * 32, scr, C.lane); continue; }
        r -= 2 * I_UP;
        if (r < 2 * I_DN) { const int f = r / I_DN; r -= f * I_DN; const int nblk = DM / 32, kb = r / nblk, nb = r % nblk;
            transpose_item(wffout + (size_t)f * DFF * DM, DM, nb * 32, kb * 64, WSP(bf16_t, f ? W_DN1 : W_DN0), DFF, nb * 32, scr, C.lane); continue; }
        r -= 2 * I_DN;
        if (r < I_INA) { const int nblk = 4096 / 32, kb = r / nblk, nb = r % nblk;
            transpose_item(win, 4096, win_srccol(nb * 32), kb * 64, WSP(bf16_t, W_IN), DM, nb * 32, scr, C.lane); continue; }
        r -= I_INA;
        if (r < I_INB) { const int nblk = 3072 / 32, kb = r / nblk, nb = r % nblk;
            transpose_item(wgate, 3072, nb * 32, kb * 64, WSP(bf16_t, W_IN), DM, 4096 + nb * 32, scr, C.lane); continue; }
        r -= I_INB;
        if (r < 3 * I_BRN) { const int gI = r / I_BRN; r -= gI * I_BRN; const int nblk = DM / 32, kb = r / nblk, nb = r % nblk;
            transpose_item(wbr + (size_t)gI * 512 * DM, DM, nb * 32, kb * 64, WSP(bf16_t, W_BR) + (size_t)gI * DM * 512, 512, nb * 32, scr, C.lane); continue; }
        r -= 3 * I_BRN;
        { const int nblk = DM / 32, kb = r / nblk, nb = r % nblk;
            transpose_item(wout, DM, nb * 32, kb * 64, WSP(bf16_t, W_OUT), DM, nb * 32, scr, C.lane); }
    }
}

__device__ __forceinline__ void prologue_misc(const Ctx& C0) {
    const Ctx C = rectx(C0);
    const int gtid = C.bx * NTHREADS + C.tid, NT = C.G * NTHREADS;
    {
        const float* relb = C.in[I_RELB];
        float* ta = WSP(float, WS_TBLA); float* tb = WSP(float, WS_TBLB);
        for (int i = gtid; i < 3 * 8 * 192; i += NT) { const int p = i / (8 * 192), h = (i / 192) % 8, idx = i % 192, rel = idx - 32; const int dil = (p == 0) ? 1 : (p == 1 ? 4 : 16);
            ta[i] = (rel >= 0 && rel <= 128) ? relb[t5_bucket(rel * dil) * 12 + h] * LOG2E : NEGBIG; }
        for (int i = gtid; i < 4 * 4224; i += NT) { const int h = i / 4224, dist = (i % 4224) - 128;
            tb[i] = (dist >= 0) ? relb[t5_bucket(dist) * 12 + 8 + h] * LOG2E : NEGBIG; }
        if (gtid < DEPTH) { const float* lv = C.in[I_LAMV] + gtid * 256; float a = 0.f, b = 0.f;
            for (int i = 0; i < 64; ++i) { a += lv[i] * lv[64 + i]; b += lv[128 + i] * lv[192 + i]; }
            const float lam_init = 0.8f - 0.6f * expf(-0.3f * (float)gtid);
            WSP(float, WS_LAM)[gtid] = expf(a) - expf(b) + lam_init; }
    }
    {
        LAS float* sc = (LAS float*)C.lds;
        LAS float* red = (LAS float*)(C.lds + 16384);
        const float* cin = C.in[I_C];
        for (int i = C.tid; i < 4096; i += NTHREADS) sc[i] = siluf_(cin[i]);
        __syncthreads();
        for (int it = C.bx; it < 2 * 144; it += C.G) {
            const int l = it / 144, cb = it % 144; const int e = cb * 64 + C.lane;
            const float* w = C.in[I_WADA] + (size_t)l * DM * 9216 + e;
            float a0 = 0.f, a1 = 0.f, a2 = 0.f, a3 = 0.f; const int d0 = C.wave * 128;
#pragma unroll 8
            for (int d = 0; d < 128; ++d) { const float wv = w[(size_t)(d0 + d) * 9216]; a0 += sc[d0 + d] * wv; a1 += sc[1024 + d0 + d] * wv; a2 += sc[2048 + d0 + d] * wv; a3 += sc[3072 + d0 + d] * wv; }
            red[(C.wave * 4 + 0) * 64 + C.lane] = a0; red[(C.wave * 4 + 1) * 64 + C.lane] = a1; red[(C.wave * 4 + 2) * 64 + C.lane] = a2; red[(C.wave * 4 + 3) * 64 + C.lane] = a3;
            __syncthreads();
            if (C.tid < 256) { const int b = C.tid >> 6, ln = C.tid & 63; float s = 0.f;
#pragma unroll
                for (int w8 = 0; w8 < 8; ++w8) s += red[(w8 * 4 + b) * 64 + ln];
                const int ee = cb * 64 + ln;
                WSP(float, WS_MOD)[((size_t)l * 4 + b) * 9216 + ee] = s + C.in[I_BADA][l * 9216 + ee]; }
            __syncthreads();
        }
    }
}

__device__ __forceinline__ void norm_phase(const Ctx& C0, int l, int which) {
    const Ctx C = rectx(C0);
    const int gw = C.vcu * 8 + C.wave, NGW = C.G * 8;
    const float* g = C.in[I_NORMG] + ((size_t)l * 3 + which) * DM;
    const float* mod = WSP(float, WS_MOD) + (size_t)l * 4 * 9216;
    bf16_t* H = WSP(bf16_t, WS_H);
    for (int row = gw; row < M; row += NGW) {
        const int b = row >> 12;
        const f32x4* xr = (const f32x4*)(((l == 0 && which == 0) ? C.in[I_X] : C.out) + (size_t)row * DM) + C.lane;
        const f32x4* sh = (const f32x4*)(mod + (size_t)b * 9216 + (3 * which) * 1024) + C.lane;
        const f32x4* scl = (const f32x4*)(mod + (size_t)b * 9216 + (3 * which + 1) * 1024) + C.lane;
        const f32x4* gg = (const f32x4*)g + C.lane;
        f32x4 v[4]; float s = 0.f;
#pragma unroll
        for (int j = 0; j < 4; ++j) { v[j] = xr[64 * j]; s += (v[j].x * v[j].x + v[j].y * v[j].y) + (v[j].z * v[j].z + v[j].w * v[j].w); }
        const float rstd = 1.0f / sqrtf(wave_sum(s, C.lane) * (1.0f / DM) + EPS);
        u32x2* o8 = (u32x2*)(H + (size_t)row * DM) + C.lane;
#pragma unroll
        for (int j = 0; j < 4; ++j) { const f32x4 gv = gg[64 * j], sv = scl[64 * j], hv = sh[64 * j];
            f32x4 y = (v[j] * rstd) * gv; y = y * (sv + 1.0f) + hv;
            u32x2 w; w.x = pk2(y.x, y.y); w.y = pk2(y.z, y.w); o8[64 * j] = w; }
    }
}

__device__ __forceinline__ void qknorm_phase(const Ctx& C0, int l) {
    const Ctx C = rectx(C0);
    const int gw = C.vcu * 8 + C.wave, NGW = C.G * 8;
    const float* qkg = C.in[I_QKG] + (size_t)l * 6 * 64;
    bf16_t* proj = WSP(bf16_t, WS_PROJ);
    const int d0 = (C.lane & 7) * 8, grp = C.lane >> 3;
    for (int row = gw; row < M; row += NGW) {
#pragma unroll
        for (int sec = 0; sec < 4; ++sec) {
            const int cbase = (sec == 0) ? C_QA : (sec == 1) ? C_KA : (sec == 2) ? C_QB : C_KB;
            int gi; float sc;
            if (sec == 0) { gi = 0; sc = QSCALE; } else if (sec == 1) { gi = 1; sc = 1.f; } else if (sec == 2) { gi = 2 + (grp & 1); sc = QSCALE; } else { gi = 4 + (grp & 1); sc = 1.f; }
            u32x4* p = (u32x4*)(proj + (size_t)row * PROJ_W + cbase + C.lane * 8);
            const u32x4 w = *p;
            float x[8] = {bf_lo(w.x), bf_hi(w.x), bf_lo(w.y), bf_hi(w.y), bf_lo(w.z), bf_hi(w.z), bf_lo(w.w), bf_hi(w.w)};
            float s = 0.f;
#pragma unroll
            for (int i = 0; i < 8; ++i) s += x[i] * x[i];
            s += shx(s, 1, C.lane); s += shx(s, 2, C.lane); s += shx(s, 4, C.lane);
            const float r = sc / sqrtf(s * (1.0f / 64.0f) + EPS);
            const f32x4 g0 = *(const f32x4*)(qkg + gi * 64 + d0), g1 = *(const f32x4*)(qkg + gi * 64 + d0 + 4);
            u32x4 o; o.x = pk2(x[0] * r * g0.x, x[1] * r * g0.y); o.y = pk2(x[2] * r * g0.z, x[3] * r * g0.w); o.z = pk2(x[4] * r * g1.x, x[5] * r * g1.y); o.w = pk2(x[6] * r * g1.z, x[7] * r * g1.w);
            *p = o;
        }
    }
}

__device__ __forceinline__ void conv_phase(const Ctx& C0, int l) {
    const Ctx C = rectx(C0);
    const bf16_t* proj = WSP(const bf16_t, WS_PROJ); bf16_t* Y = WSP(bf16_t, WS_Y);
    LAS bf16_t* ut = (LAS bf16_t*)C.lds;
    LAS float* yt = (LAS float*)(C.lds + 65536);
    const int c = C.tid;
    float w[31];
#pragma unroll
    for (int j = 0; j < 31; ++j) w[j] = C.in[I_CONVW][((size_t)l * 31 + j) * 512 + c];
    const float cb = C.in[I_CONVB][l * 512 + c];
    const float* lng = C.in[I_CLNG] + l * 512; const float* lnb = C.in[I_CLNB] + l * 512;
    for (int un = C.vcu; un < M / 32; un += C.G) {
        const int row0 = un * 32, t0 = row0 & (SEQ - 1);
        for (int i = C.tid; i < 62 * 64; i += NTHREADS) { const int rr = i >> 6, ch = i & 63; const int t = t0 - 30 + rr;
            u32x4 v = (u32x4){0u, 0u, 0u, 0u};
            if (t >= 0) v = *(const u32x4*)(proj + (size_t)(row0 - 30 + rr) * PROJ_W + C_U + ch * 8);
            *(LAS u32x4*)(ut + rr * 512 + ch * 8) = v; }
        __syncthreads();
#pragma unroll 1
        for (int g8 = 0; g8 < 4; ++g8) {
            float uu[38];
#pragma unroll
            for (int i = 0; i < 38; ++i) uu[i] = __uint_as_float((unsigned)ut[(g8 * 8 + i) * 512 + c] << 16);
#pragma unroll
            for (int i = 0; i < 8; ++i) { float a = cb;
#pragma unroll
                for (int j = 0; j < 31; ++j) a += w[j] * uu[i + j];
                yt[(g8 * 8 + i) * 512 + c] = a; }
        }
        __syncthreads();
#pragma unroll
        for (int rr = 0; rr < 4; ++rr) { const int r = C.wave * 4 + rr; const LAS float* yr = yt + r * 512 + C.lane * 8;
            float x[8]; float s = 0.f;
#pragma unroll
            for (int i = 0; i < 8; ++i) { x[i] = yr[i]; s += x[i]; }
            const float mean = wave_sum(s, C.lane) * (1.0f / 512.0f); float q = 0.f;
#pragma unroll
            for (int i = 0; i < 8; ++i) { x[i] -= mean; q += x[i] * x[i]; }
            const float rstd = 1.0f / sqrtf(wave_sum(q, C.lane) * (1.0f / 512.0f) + EPS);
            float o[8];
#pragma unroll
            for (int i = 0; i < 8; ++i) { const float v = x[i] * rstd * lng[C.lane * 8 + i] + lnb[C.lane * 8 + i]; o[i] = siluf_(v); }
            u32x4 pw; pw.x = pk2(o[0], o[1]); pw.y = pk2(o[2], o[3]); pw.z = pk2(o[4], o[5]); pw.w = pk2(o[6], o[7]);
            *(u32x4*)(Y + (size_t)(row0 + r) * Y_W + 1024 + C.lane * 8) = pw; }
        __syncthreads();
    }
}

__device__ __forceinline__ s16x4 vtr(const LAS unsigned char* p) { return __builtin_bit_cast(s16x4, __builtin_amdgcn_ds_read_tr16_b64_v4i16((LAS s16x4*)p)); }
__device__ __forceinline__ bf16x8 vfrag(const LAS unsigned char* p) { const s16x4 lo = vtr(p), hi = vtr(p + 512); return (bf16x8){lo[0], lo[1], lo[2], lo[3], hi[0], hi[1], hi[2], hi[3]}; }
__device__ __forceinline__ bf16x8 pfrag(const f32x16& p, int s) {
    u32x4 w; w.x = pk2(p[8 * s + 0], p[8 * s + 1]); w.y = pk2(p[8 * s + 2], p[8 * s + 3]); w.z = pk2(p[8 * s + 4], p[8 * s + 5]); w.w = pk2(p[8 * s + 6], p[8 * s + 7]);
    return __builtin_bit_cast(bf16x8, w);
}

__device__ __forceinline__ void dilated_phase(const Ctx& C0) {
    const Ctx C = rectx(C0);
    const bf16_t* proj = WSP(const bf16_t, WS_PROJ);
    LAS unsigned char* Kl = C.lds;
    LAS unsigned char* Vl = C.lds + 49152;
    LAS float* tbl = (LAS float*)(C.lds + 98304);
    const int lane = C.lane, r32 = lane & 31, hi = lane >> 5, w = C.wave;
    const int vlane = ((lane >> 4) & 1) * 32 + (lane & 3) * 8 + (4 * hi + ((lane & 15) >> 2)) * 64;
    for (int uid = C.vcu; uid < 1536; uid += C.G) {
        const int p = uid >> 9, rem = uid & 511, bh = rem >> 4, ru = rem & 15;
        const int dil = (p == 0) ? 1 : (p == 1 ? 4 : 16), nu = 16 / dil, r = ru / nu, u = ru % nu;
        const int b = bh >> 3, h = bh & 7;
        const size_t tokbase = (size_t)b * SEQ;
        if (C.tid < 192) tbl[C.tid] = WSP(const float, WS_TBLA)[(p * 8 + h) * 192 + C.tid];
        u32x4 kreg[6], vreg[6];
#pragma unroll
        for (int i = 0; i < 6; ++i) { const int idx = C.tid + 512 * i;
            { const int chunk = idx / 384, key = idx - chunk * 384; const int sidx = 256 * u - 128 + key;
              kreg[i] = (u32x4){0u, 0u, 0u, 0u};
              if (sidx >= 0) kreg[i] = *(const u32x4*)(proj + (tokbase + (size_t)sidx * dil + r) * PROJ_W + C_KA + h * 64 + chunk * 8); }
            { const int dblk = idx / 1536, rm = idx - dblk * 1536, ks = rm >> 6, k16 = (rm & 63) >> 2, c4 = rm & 3; const int sidx = 256 * u - 128 + ks * 16 + k16;
              vreg[i] = (u32x4){0u, 0u, 0u, 0u};
              if (sidx >= 0) vreg[i] = *(const u32x4*)(proj + (tokbase + (size_t)sidx * dil + r) * PROJ_W + C_VA + h * 64 + dblk * 32 + c4 * 8); }
        }
#pragma unroll
        for (int i = 0; i < 6; ++i) { const int idx = C.tid + 512 * i; *(LAS u32x4*)(Kl + idx * 16) = kreg[i]; *(LAS u32x4*)(Vl + idx * 16) = vreg[i]; }
        const int iq = 32 * w + r32; const size_t tq = tokbase + (size_t)(256 * u + iq) * dil + r;
        bf16x8 qf[4];
#pragma unroll
        for (int d0 = 0; d0 < 4; ++d0) qf[d0] = *(const bf16x8*)(proj + tq * PROJ_W + C_QA + h * 64 + d0 * 16 + hi * 8);
        __syncthreads();
        f32x16 S[5]; float mx = NEGBIG;
#pragma unroll
        for (int s = 0; s < 5; ++s) {
            const bool skip = (u == 0) && (w + s < 4);
            if (!skip) {
                f32x16 a;
#pragma unroll
                for (int rg = 0; rg < 16; ++rg) a[rg] = tbl[(r32 + 5 - 4 * hi) + (128 - 32 * s) + 27 - ((rg & 3) + 8 * (rg >> 2))];
                const int jj0 = 32 * (w + s);
#pragma unroll
                for (int d0 = 0; d0 < 4; ++d0) { const bf16x8 kf = *(const LAS bf16x8*)(Kl + (2 * d0 + hi) * 6144 + (jj0 + r32) * 16);
                    a = __builtin_amdgcn_mfma_f32_32x32x16_bf16(kf, qf[d0], a, 0, 0, 0); }
                S[s] = a;
#pragma unroll
                for (int rg = 0; rg < 16; ++rg) mx = fmaxf(mx, a[rg]);
            } else {
#pragma unroll
                for (int rg = 0; rg < 16; ++rg) S[s][rg] = NEGBIG;
            }
        }
        mx = fmaxf(mx, shx(mx, 32, C.lane));
        float den = 0.f;
#pragma unroll
        for (int s = 0; s < 5; ++s)
#pragma unroll
            for (int rg = 0; rg < 16; ++rg) { const float e = fast_exp2(S[s][rg] - mx); S[s][rg] = e; den += e; }
        den += shx(den, 32, C.lane);
        f32x16 o[2]; o[0] = (f32x16){}; o[1] = (f32x16){};
#pragma unroll
        for (int s = 0; s < 5; ++s) {
            const bool skip = (u == 0) && (w + s < 4);
            if (!skip) {
#pragma unroll
                for (int s16 = 0; s16 < 2; ++s16) { const int ksg = 2 * (w + s) + s16; const bf16x8 pf = pfrag(S[s], s16);
#pragma unroll
                    for (int dblk = 0; dblk < 2; ++dblk) { const bf16x8 vf = vfrag(Vl + dblk * 24576 + ksg * 1024 + vlane);
                        o[dblk] = __builtin_amdgcn_mfma_f32_32x32x16_bf16(vf, pf, o[dblk], 0, 0, 0); } }
            }
        }
        const float rden = 1.0f / den;
        bf16_t* Op; int opitch;
        if (p == 0) { Op = WSP(bf16_t, WS_Y); opitch = Y_W; } else { Op = WSP(bf16_t, WS_H) + (size_t)(p - 1) * M * 512; opitch = 512; }
        bf16_t* orow = Op + tq * opitch + h * 64;
#pragma unroll
        for (int dblk = 0; dblk < 2; ++dblk)
#pragma unroll
            for (int rg = 0; rg < 4; ++rg) { u32x2 wv; wv.x = pk2(o[dblk][4 * rg] * rden, o[dblk][4 * rg + 1] * rden); wv.y = pk2(o[dblk][4 * rg + 2] * rden, o[dblk][4 * rg + 3] * rden);
                *(u32x2*)(orow + 32 * dblk + 8 * rg + 4 * hi) = wv; }
        if (hi == 0) WSP(float, WS_LSE)[((size_t)p * M + tq) * 8 + h] = mx + log2f(den);
        __syncthreads();
    }
}

__device__ __forceinline__ void combine_phase(const Ctx& C0) {
    const Ctx C = rectx(C0);
    const int gtid = C.bx * NTHREADS + C.tid, NT = C.G * NTHREADS;
    bf16_t* Y = WSP(bf16_t, WS_Y); const bf16_t* O1 = WSP(const bf16_t, WS_H); const bf16_t* O2 = O1 + (size_t)M * 512; const float* lse = WSP(const float, WS_LSE);
    for (int i = gtid; i < M * 64; i += NT) { const int row = i >> 6, c8 = i & 63, h = c8 >> 3;
        const float l0 = lse[(size_t)row * 8 + h], l1 = lse[((size_t)M + row) * 8 + h], l2 = lse[((size_t)2 * M + row) * 8 + h];
        const float mx = fmaxf(l0, fmaxf(l1, l2)); float w0 = fast_exp2(l0 - mx), w1 = fast_exp2(l1 - mx), w2 = fast_exp2(l2 - mx); const float rs = 1.0f / (w0 + w1 + w2); w0 *= rs; w1 *= rs; w2 *= rs;
        u32x4* yp = (u32x4*)(Y + (size_t)row * Y_W + c8 * 8);
        const u32x4 a = *yp, b = *(const u32x4*)(O1 + (size_t)row * 512 + c8 * 8), c = *(const u32x4*)(O2 + (size_t)row * 512 + c8 * 8);
        u32x4 o;
        o.x = pk2(w0 * bf_lo(a.x) + w1 * bf_lo(b.x) + w2 * bf_lo(c.x), w0 * bf_hi(a.x) + w1 * bf_hi(b.x) + w2 * bf_hi(c.x));
        o.y = pk2(w0 * bf_lo(a.y) + w1 * bf_lo(b.y) + w2 * bf_lo(c.y), w0 * bf_hi(a.y) + w1 * bf_hi(b.y) + w2 * bf_hi(c.y));
        o.z = pk2(w0 * bf_lo(a.z) + w1 * bf_lo(b.z) + w2 * bf_lo(c.z), w0 * bf_hi(a.z) + w1 * bf_hi(b.z) + w2 * bf_hi(c.z));
        o.w = pk2(w0 * bf_lo(a.w) + w1 * bf_lo(b.w) + w2 * bf_lo(c.w), w0 * bf_hi(a.w) + w1 * bf_hi(b.w) + w2 * bf_hi(c.w));
        *yp = o; }
}

__device__ __forceinline__ void diff_unit(const Ctx& C, int l, int b, int h, int qb) {
    const bf16_t* proj = WSP(const bf16_t, WS_PROJ);
    LAS float* tbl = (LAS float*)(C.lds + 65536);
    const int lane = C.lane, r32 = lane & 31, hi = lane >> 5, w = C.wave, comp = w >> 2, wq = w & 3;
    const int vlane = ((lane >> 4) & 1) * 32 + (lane & 3) * 8 + (4 * hi + ((lane & 15) >> 2)) * 64;
    const size_t tokbase = (size_t)b * SEQ; const int q0 = qb * 128;
    const int nkt = 2 * (qb + 1);
    for (int i = C.tid; i < 4224; i += NTHREADS) tbl[i] = WSP(const float, WS_TBLB)[h * 4224 + i];
    u32x4 kreg[2], vreg[2];
#define DIFF_LOAD(kt) do { _Pragma("unroll") for (int i_ = 0; i_ < 2; ++i_) { const int idx = C.tid + 512 * i_; \
        { const int cp = idx >> 9, chunk = (idx & 511) >> 6, key = idx & 63; kreg[i_] = *(const u32x4*)(proj + (tokbase + (size_t)(kt) * 64 + key) * PROJ_W + C_KB + h * 128 + cp * 64 + chunk * 8); } \
        { const int dblk = idx >> 8, ks = (idx & 255) >> 6, k16 = (idx & 63) >> 2, c4 = idx & 3; vreg[i_] = *(const u32x4*)(proj + (tokbase + (size_t)(kt) * 64 + ks * 16 + k16) * PROJ_W + C_VB + h * 128 + dblk * 32 + c4 * 8); } } } while (0)
#define DIFF_STORE(buf) do { _Pragma("unroll") for (int i_ = 0; i_ < 2; ++i_) { const int idx = C.tid + 512 * i_; \
        *(LAS u32x4*)(C.lds + (buf) * 32768 + idx * 16) = kreg[i_]; *(LAS u32x4*)(C.lds + (buf) * 32768 + 16384 + idx * 16) = vreg[i_]; } } while (0)
    DIFF_LOAD(0);
    const int qrow = q0 + 32 * wq + r32;
    bf16x8 qf[4];
#pragma unroll
    for (int d0 = 0; d0 < 4; ++d0) qf[d0] = *(const bf16x8*)(proj + (tokbase + qrow) * PROJ_W + C_QB + h * 128 + comp * 64 + d0 * 16 + hi * 8);
    DIFF_STORE(0);
    __syncthreads();
    f32x16 o[4]; o[0] = (f32x16){}; o[1] = (f32x16){}; o[2] = (f32x16){}; o[3] = (f32x16){};
    float mrun = NEGBIG, lrun = 0.f;
#pragma unroll 1
    for (int kt = 0; kt < nkt; ++kt) {
        const int buf = kt & 1;
        if (kt + 1 < nkt) DIFF_LOAD(kt + 1);
        const LAS unsigned char* Kc = C.lds + buf * 32768 + comp * 8192;
        const LAS unsigned char* Vc = C.lds + buf * 32768 + 16384;
        f32x16 S0, S1;
        {
            const LAS float* tb1 = tbl + (qrow - 64 * kt + 128 - 4 * hi - 27 - 32);
#pragma unroll
            for (int rg = 0; rg < 16; ++rg) { S0[rg] = tb1[32 + 27 - ((rg & 3) + 8 * (rg >> 2))]; S1[rg] = tb1[27 - ((rg & 3) + 8 * (rg >> 2))]; }
#pragma unroll
            for (int d0 = 0; d0 < 4; ++d0) {
                const bf16x8 k0 = *(const LAS bf16x8*)(Kc + (2 * d0 + hi) * 1024 + r32 * 16);
                const bf16x8 k1 = *(const LAS bf16x8*)(Kc + (2 * d0 + hi) * 1024 + (32 + r32) * 16);
                S0 = __builtin_amdgcn_mfma_f32_32x32x16_bf16(k0, qf[d0], S0, 0, 0, 0);
                S1 = __builtin_amdgcn_mfma_f32_32x32x16_bf16(k1, qf[d0], S1, 0, 0, 0);
            }
        }
        float mx = NEGBIG;
#pragma unroll
        for (int rg = 0; rg < 16; ++rg) mx = fmaxf(mx, fmaxf(S0[rg], S1[rg]));
        mx = fmaxf(mx, shx(mx, 32, C.lane));
        if (__any(mx > mrun + 8.0f)) {
            const float mnew = fmaxf(mrun, mx);
            const float alpha = fast_exp2(mrun - mnew);
            lrun *= alpha;
#pragma unroll
            for (int d = 0; d < 4; ++d)
#pragma unroll
                for (int rg = 0; rg < 16; ++rg) o[d][rg] *= alpha;
            mrun = mnew;
        }
        float ps = 0.f;
#pragma unroll
        for (int rg = 0; rg < 16; ++rg) { S0[rg] = fast_exp2(S0[rg] - mrun); S1[rg] = fast_exp2(S1[rg] - mrun); ps += S0[rg] + S1[rg]; }
        lrun += ps;
#pragma unroll
        for (int kk = 0; kk < 2; ++kk)
#pragma unroll
            for (int s16 = 0; s16 < 2; ++s16) { const int ksg = 2 * kk + s16; const bf16x8 pf = pfrag(kk ? S1 : S0, s16);
#pragma unroll
                for (int dblk = 0; dblk < 4; ++dblk) { const bf16x8 vf = vfrag(Vc + dblk * 4096 + ksg * 1024 + vlane);
                    o[dblk] = __builtin_amdgcn_mfma_f32_32x32x16_bf16(vf, pf, o[dblk], 0, 0, 0); } }
        if (kt + 1 < nkt) DIFF_STORE(buf ^ 1);
        __syncthreads();
    }
#undef DIFF_LOAD
#undef DIFF_STORE
    lrun += shx(lrun, 32, C.lane);
    const float rl = 1.0f / lrun;
    const float lam = WSP(const float, WS_LAM)[l];
    const float lam_init = 0.8f - 0.6f * expf(-0.3f * (float)l);
    LAS float* ex = (LAS float*)(C.lds + wq * 16384);
    if (comp == 1) {
#pragma unroll
        for (int dblk = 0; dblk < 4; ++dblk)
#pragma unroll
            for (int rg = 0; rg < 16; ++rg) ex[(32 * dblk + crow(rg, hi)) * 32 + r32] = o[dblk][rg] * rl * lam;
    }
    __syncthreads();
    if (comp == 0) {
        float ss = 0.f;
#pragma unroll
        for (int dblk = 0; dblk < 4; ++dblk)
#pragma unroll
            for (int rg = 0; rg < 16; ++rg) { const float v = o[dblk][rg] * rl - ex[(32 * dblk + crow(rg, hi)) * 32 + r32]; o[dblk][rg] = v; ss += v * v; }
        ss += shx(ss, 32, C.lane);
        const float rs = (1.0f - lam_init) / sqrtf(ss * (1.0f / 128.0f) + EPS);
        const float* sg = C.in[I_SUBLN] + l * 128;
        bf16_t* yrow = WSP(bf16_t, WS_Y) + (tokbase + qrow) * Y_W + 512 + h * 128;
#pragma unroll
        for (int dblk = 0; dblk < 4; ++dblk)
#pragma unroll
            for (int rg = 0; rg < 4; ++rg) { const int d = 32 * dblk + 8 * rg + 4 * hi; const f32x4 g = *(const f32x4*)(sg + d);
                u32x2 wv; wv.x = pk2(o[dblk][4 * rg] * rs * g.x, o[dblk][4 * rg + 1] * rs * g.y); wv.y = pk2(o[dblk][4 * rg + 2] * rs * g.z, o[dblk][4 * rg + 3] * rs * g.w);
                *(u32x2*)(yrow + d) = wv; }
    }
    __syncthreads();
}
__device__ __forceinline__ void diff_phase(const Ctx& C0, int l) {
    const Ctx C = rectx(C0);
    for (int pi = C.vcu; pi < 256; pi += C.G) {
        const int bh = pi >> 4, j = pi & 15;
        diff_unit(C, l, bh >> 2, bh & 3, 31 - j);
        diff_unit(C, l, bh >> 2, bh & 3, j);
    }
}


#define XB_TMO      128
#define XB_XCNT(j)  (256  + 64 * (j))
#define XB_XSUB(j)  (1280 + 64 * (j))
#define XB_XGEN(j)  (2304 + 64 * (j))
#define XB_TOP      3328
#define XB_TOPGEN   3392
#define XCD_BAR_WORDS 3456
#define XB_SPIN_CAP (1u << 18)
__device__ __forceinline__ unsigned xb_ld(unsigned* p)              { return __hip_atomic_load(p, __ATOMIC_RELAXED, __HIP_MEMORY_SCOPE_AGENT); }
__device__ __forceinline__ unsigned xb_add(unsigned* p, unsigned v) { return __hip_atomic_fetch_add(p, v, __ATOMIC_RELAXED, __HIP_MEMORY_SCOPE_AGENT); }
__device__ __forceinline__ unsigned xb_xcc_id() { return (unsigned)__builtin_amdgcn_s_getreg((3 << 11) | 20) & 0xFu; }
#define XB_SPIN(cond, bar) do { unsigned _sp = 0; while (cond) { __builtin_amdgcn_s_sleep(1); \
    if ((++_sp & 255u) == 0u) { if (xb_ld(&(bar)[XB_TMO])) break; if (_sp > XB_SPIN_CAP) { atomicAdd(&(bar)[XB_TMO], 1u); break; } } } } while (0)
struct XcdBarrier { unsigned* bar; unsigned x; volatile LAS unsigned* st; };
__device__ __forceinline__ XcdBarrier xcd_barrier_post(unsigned* bar, volatile LAS unsigned* st) {
    XcdBarrier b; b.bar = bar; b.x = xb_xcc_id(); b.st = st;
    if (threadIdx.x == 0) (void)xb_add(&bar[XB_XCNT(b.x)], 1u);
    return b;
}
__device__ __forceinline__ void xcd_barrier_complete(unsigned* bar, unsigned x, unsigned& nloc, unsigned& nx) {
    const unsigned G = gridDim.x * gridDim.y * gridDim.z;
    unsigned sum, cnt, mine, sp = 0u;
    for (;;) {
        sum = 0u; cnt = 0u; mine = 0u;
#pragma unroll
        for (unsigned j = 0; j < 16; ++j) { const unsigned c = xb_ld(&bar[XB_XCNT(j)]); sum += c; cnt += (c > 0u) ? 1u : 0u; mine = (j == x) ? c : mine; }
        if (sum == G) break;
        __builtin_amdgcn_s_sleep(1);
        if ((++sp & 255u) == 0u) { if (xb_ld(&bar[XB_TMO])) break; if (sp > XB_SPIN_CAP) { atomicAdd(&bar[XB_TMO], 1u); break; } }
    }
    nloc = mine > 0u ? mine : 1u; nx = cnt > 0u ? cnt : 1u;
}
__device__ __forceinline__ void xcd_barrier(const XcdBarrier& b) {
    asm volatile("s_waitcnt vmcnt(0)" ::: "memory");
    __syncthreads();
    if (threadIdx.x == 0) {
        unsigned* bar = b.bar;
        __builtin_amdgcn_s_waitcnt(0);
        unsigned nloc = b.st[0], nx = b.st[1];
        if (nloc == 0u) { xcd_barrier_complete(bar, b.x, nloc, nx); b.st[0] = nloc; b.st[1] = nx; }
        const unsigned old = xb_add(&bar[XB_XSUB(b.x)], 1u);
        const unsigned gen = old / nloc;
        if (old + 1u == (gen + 1u) * nloc) {
            __builtin_amdgcn_fence(__ATOMIC_RELEASE, "agent");
            asm volatile("s_waitcnt vmcnt(0)" ::: "memory");
            const unsigned og = xb_add(&bar[XB_TOP], 1u);
            const unsigned tg = og / nx;
            if (og + 1u == (tg + 1u) * nx) xb_add(&bar[XB_TOPGEN], 1u);
            else XB_SPIN(xb_ld(&bar[XB_TOPGEN]) == tg, bar);
            __builtin_amdgcn_fence(__ATOMIC_ACQUIRE, "agent");
            xb_add(&bar[XB_XGEN(b.x)], 1u);
            asm volatile("s_waitcnt vmcnt(0)" ::: "memory");
        } else {
            XB_SPIN(xb_ld(&bar[XB_XGEN(b.x)]) == gen, bar);
            __builtin_amdgcn_fence(__ATOMIC_ACQUIRE, "agent");
            asm volatile("s_waitcnt vmcnt(0)" ::: "memory");
        }
    }
    __syncthreads();
}
#ifndef PROBE_STEP
#define PROBE_STEP -1
#endif
constexpr int LDS_BARST = 131072 + 512;

__global__ void __launch_bounds__(NTHREADS, 2) fwd_megakernel(Params P) {
    extern __shared__ __attribute__((aligned(16))) unsigned char lds_raw[];
    cg::grid_group grid = cg::this_grid();
    Ctx CB;
    CB.lds = (LAS unsigned char*)lds_raw;
    CB.tid = 0; CB.lane = 0; CB.wave = 0;
    CB.G = gridDim.x; CB.bx = blockIdx.x; CB.vcu = (CB.G % 8 == 0) ? (CB.bx % 8) * (CB.G / 8) + CB.bx / 8 : CB.bx;
    CB.in = P.in; CB.out = P.out; CB.ws = P.ws;

    unsigned* barw = (unsigned*)(P.ws + WS_CTL);
    if (blockIdx.x == 0) for (int i = threadIdx.x; i < XCD_BAR_WORDS; i += NTHREADS) __hip_atomic_store(barw + i, 0u, __ATOMIC_RELAXED, __HIP_MEMORY_SCOPE_AGENT);
    volatile LAS unsigned* barst = (volatile LAS unsigned*)(CB.lds + LDS_BARST);
    if (threadIdx.x < 2) barst[threadIdx.x] = 0u;
    __syncthreads();
    XcdBarrier xbar; xbar.bar = barw; xbar.x = 0; xbar.st = barst;
    constexpr int NSTEP = 14;
    constexpr int NS2 = NSTEP + ((PROBE_STEP >= 0) ? 1 : 0);
#pragma unroll 1
    for (int step = 0; step < DEPTH * NS2; ++step) {
        const int l = step / NS2; const int s_ = step - l * NS2;
        const int s = (PROBE_STEP >= 0 && s_ > PROBE_STEP) ? s_ - 1 : s_;
        const int rep = (PROBE_STEP >= 0 && s_ == PROBE_STEP + 1) ? 1 : 0;
        {
        const Ctx C = rectx(CB);
        const float* modl = WSP(const float, WS_MOD) + (size_t)l * 4 * 9216;
        switch (s) {
        case 0: if (l == 0) prologue_misc(C); convert_weights(C, l); break;
        case 1: norm_phase(C, l, 0); break;
        case 4: norm_phase(C, l, 1); break;
        case 11: norm_phase(C, l, 2); break;
        case 2: case 12: {
            const int f = (s == 12);
            pg8::Gemm g{WSP(const bf16_t, WS_H), WSP(const bf16_t, f ? W_UP1 : W_UP0), DM, DM, DM, 0, 0};
            pg8::TileOrder S; S.init(M, NUP, C.G, C.bx, 1);
            pg8::EpiSwiGLU E{WSP(bf16_t, WS_PROJ)};
            pg8::gemm_phase(C.lds, g, S, E);
        } break;
        case 3: case 13: {
            const int f = (s == 13);
            pg8::Gemm g{WSP(const bf16_t, WS_PROJ), WSP(const bf16_t, f ? W_DN1 : W_DN0), DFF, DFF, DFF, 0, 0};
            pg8::TileOrder S; S.init(M, DM, C.G, C.bx, 1);
            pg8::EpiResidual E{(l == 0 && !f && !rep) ? C.in[I_X] : C.out, C.out, modl + (f ? 8 : 2) * 1024, rep ? 0.0f : 0.5f};
            pg8::gemm_phase(C.lds, g, S, E);
        } break;
        case 5: {
            pg8::Gemm g{WSP(const bf16_t, WS_H), WSP(const bf16_t, W_IN), DM, DM, DM, 0, 0};
            pg8::TileOrder S; S.init(M, NIN, C.G, C.bx, 1);
            pg8::EpiInGate E{WSP(bf16_t, WS_PROJ), WSP(bf16_t, WS_GATES), C.in[I_BGATE] + (size_t)l * GATE_W};
            pg8::gemm_phase(C.lds, g, S, E);
        } break;
        case 6: qknorm_phase(C, l); conv_phase(C, l); break;
        case 7: dilated_phase(C); break;
        case 8: if (rep == 0) combine_phase(C); diff_phase(C, l); break;
        case 9: {
            pg8::Gemm g{WSP(const bf16_t, WS_Y), WSP(const bf16_t, W_BR), Y_W, 512, 512, 512, (long)DM * 512};
            pg8::TileOrder S; S.init(M, DM, C.G, C.bx, 3);
            pg8::EpiBranch E{WSP(const bf16_t, WS_GATES), WSP(bf16_t, WS_H)};
            pg8::gemm_phase(C.lds, g, S, E);
        } break;
        case 10: {
            pg8::Gemm g{WSP(const bf16_t, WS_H), WSP(const bf16_t, W_OUT), DM, DM, DM, 0, 0};
            pg8::TileOrder S; S.init(M, DM, C.G, C.bx, 1);
            pg8::EpiResidual E{C.out, C.out, modl + 5 * 1024, rep ? 0.0f : 1.0f};
            pg8::gemm_phase(C.lds, g, S, E);
        } break;
        default: break;
        }
        }
        if (step == 0) { grid.sync(); xbar = xcd_barrier_post(barw, barst); }
        else if (step + 1 < DEPTH * NS2) xcd_barrier(xbar);
    }
}

extern "C" void kernel_launch(void* const* d_in, const int* in_sizes, int n_in, void* d_out, int out_size, void* d_ws, size_t ws_size, hipStream_t stream) {
    static int grid = 0;
    if (grid == 0) {
        int dev = 0, cus = 0, per_cu = 0;
        if (n_in != 20 || out_size != M * DM || ws_size < WS_END) { fprintf(stderr, "kernel_launch: unexpected problem shape (n_in %d out %d ws %zu)\n", n_in, out_size, ws_size); grid = -1; return; }
        hipGetDevice(&dev);
        hipDeviceGetAttribute(&cus, hipDeviceAttributeMultiprocessorCount, dev);
        hipFuncSetAttribute((const void*)fwd_megakernel, hipFuncAttributeMaxDynamicSharedMemorySize, LDS_BYTES);
        hipOccupancyMaxActiveBlocksPerMultiprocessor(&per_cu, (const void*)fwd_megakernel, NTHREADS, LDS_BYTES);
        (void)hipGetLastError();
        if (per_cu < 1) { fprintf(stderr, "kernel_launch: occupancy query says %d blocks per CU\n", per_cu); per_cu = 1; }
        grid = cus;
    }
    if (grid < 0) return;
    Params p{};
    for (int i = 0; i < 20; ++i) p.in[i] = (const float*)d_in[i];
    p.out = (float*)d_out; p.ws = (unsigned char*)d_ws; p.dbg = 0; p.pad = 0;
    void* args[] = {&p};
    hipError_t e = hipLaunchCooperativeKernel((const void*)fwd_megakernel, dim3(grid), dim3(NTHREADS), args, LDS_BYTES, stream);
    if (e != hipSuccess) fprintf(stderr, "cooperative launch failed: %s (grid %d)\n", hipGetErrorString(e), grid);
}
```
